# Optimizing an MI355X kernel written in HIP

```python
import jax, jax.numpy as jnp
from jax import lax
import numpy as np

D_MODEL = 4096
BATCH = 1
SEQ = 8192
DEPTH = 1

CHUNK = 64
N_META = 16
Q_BLOCK = 128
EPS = 1e-6

FOX_HEADS = 16
FOX_HEAD_DIM = 128
FOX_WIDTH = FOX_HEADS * FOX_HEAD_DIM

GLA_HEADS = 4
GLA_DK = 256
GLA_DV = 512
GLA_KW = GLA_HEADS * GLA_DK
GLA_VW = GLA_HEADS * GLA_DV
GLA_GATE_RANK = 16
GLA_GATE_TAU = 16.0

D_FF = 11008

IN_SIZES = (FOX_WIDTH, FOX_WIDTH, FOX_WIDTH, FOX_HEADS, GLA_KW, GLA_KW, GLA_VW, GLA_VW, GLA_GATE_RANK)
D_IN = FOX_WIDTH * 3 + FOX_HEADS + GLA_KW * 2 + GLA_VW * 2 + GLA_GATE_RANK

kernel_name = "fox_gla_gated_hybrid_macaron"


def _rmsnorm(x, g):
    x32 = x.astype(jnp.float32)
    r = x32 * lax.rsqrt(jnp.mean(x32 * x32, axis=-1, keepdims=True) + EPS)
    return (r * g.astype(jnp.float32)).astype(x.dtype)


def _swiglu(x, w1, w3, w2):
    return (jax.nn.silu(x @ w1) * (x @ w3)) @ w2


def _split_cols(p, sizes):
    idx = np.cumsum(np.array(sizes))[:-1].tolist()
    return jnp.split(p, idx, axis=-1)


def _fox_attention(q, k, v, f_logit):
    b, l, h, dh = q.shape
    scale = dh ** -0.5
    log_f = jax.nn.log_sigmoid(f_logit.astype(jnp.float32))
    c = jnp.cumsum(log_f, axis=1)
    lp = ((l + Q_BLOCK - 1) // Q_BLOCK) * Q_BLOCK
    nb = lp // Q_BLOCK
    pad = lp - l
    qp = jnp.pad(q, ((0, 0), (0, pad), (0, 0), (0, 0)))
    kp = jnp.pad(k, ((0, 0), (0, pad), (0, 0), (0, 0)))
    vp = jnp.pad(v, ((0, 0), (0, pad), (0, 0), (0, 0)))
    cp = jnp.pad(c, ((0, 0), (0, pad), (0, 0)))
    c_k = jnp.transpose(cp, (0, 2, 1))[:, :, None, :]
    k_pos = jnp.arange(lp, dtype=jnp.int32)
    q_blocks = jnp.transpose(qp.reshape(b, nb, Q_BLOCK, h, dh), (1, 0, 2, 3, 4))
    c_blocks = jnp.transpose(cp.reshape(b, nb, Q_BLOCK, h), (1, 0, 2, 3))
    starts = jnp.arange(nb, dtype=jnp.int32) * Q_BLOCK

    def one_block(args):
        qb, cb, start = args
        s = jnp.einsum('bqhd,bkhd->bhqk', qb, kp).astype(jnp.float32) * scale
        bias = jnp.transpose(cb, (0, 2, 1))[:, :, :, None] - c_k
        q_pos = start + jnp.arange(Q_BLOCK, dtype=jnp.int32)
        mask = k_pos[None, :] <= q_pos[:, None]
        s = jnp.where(mask[None, None], s + bias, -jnp.inf)
        p = jax.nn.softmax(s, axis=-1)
        return jnp.einsum('bhqk,bkhd->bqhd', p.astype(vp.dtype), vp)

    out = lax.map(one_block, (q_blocks, c_blocks, starts))
    out = jnp.transpose(out, (1, 0, 2, 3, 4)).reshape(b, lp, h, dh)
    return out[:, :l]


def _gla_chunk_causal(q, k, v, log_alpha):
    b, l, h, dk = q.shape
    dv = v.shape[-1]
    pad_left = (-N_META) % CHUNK
    pw = ((0, 0), (pad_left, 0), (0, 0), (0, 0))
    qp = jnp.pad(q, pw)
    kp = jnp.pad(k, pw)
    vp = jnp.pad(v, pw)
    lap = jnp.pad(log_alpha.astype(jnp.float32), pw)
    lt = l + pad_left
    nc = lt // CHUNK

    def to_chunks(t):
        return jnp.transpose(t.reshape(b, nc, CHUNK, h, t.shape[-1]), (1, 0, 2, 3, 4))

    qc, kc, vc, lac = to_chunks(qp), to_chunks(kp), to_chunks(vp), to_chunks(lap)
    cum = jnp.cumsum(lac, axis=2)
    total = cum[:, :, -1]
    k_dec = kc.astype(jnp.float32) * jnp.exp(total[:, :, None] - cum)

    def step(state, xs):
        q_i, k_i, v_i, tot_i = xs
        state = jnp.exp(tot_i)[..., None] * state + jnp.einsum(
            'bchk,bchv->bhkv', k_i, v_i.astype(jnp.float32))
        o_i = jnp.einsum('bchk,bhkv->bchv', q_i.astype(jnp.float32), state)
        return state, o_i

    s0 = jnp.zeros((b, h, dk, dv), jnp.float32)
    _, out = lax.scan(step, s0, (qc, k_dec, vc, total))
    out = jnp.transpose(out, (1, 0, 2, 3, 4)).reshape(b, lt, h, dv)
    return out[:, pad_left:].astype(v.dtype)


def setup_inputs(seed: int = 0) -> dict:
    key = jax.random.key(seed)
    ks = jax.random.split(key, 24)
    f32 = jnp.float32
    D = D_MODEL

    def nrm(k, shape, scale):
        return jax.random.normal(k, shape, f32) * scale

    def gain(k, shape):
        return 1.0 + 0.02 * jax.random.normal(k, shape, f32)

    return {
        "x": jax.random.normal(ks[0], (BATCH, SEQ, D), f32),
        "meta_tokens": nrm(ks[1], (N_META, D), 1.0),
        "norm1_g": gain(ks[2], (DEPTH, D)),
        "ffn1_w1": nrm(ks[3], (DEPTH, D, D_FF), D ** -0.5),
        "ffn1_w3": nrm(ks[4], (DEPTH, D, D_FF), D ** -0.5),
        "ffn1_w2": nrm(ks[5], (DEPTH, D_FF, D), D_FF ** -0.5),
        "norm_mix_g": gain(ks[6], (DEPTH, D)),
        "w_in": nrm(ks[7], (DEPTH, D, D_IN), D ** -0.5),
        "fox_f_bias": 2.0 + 0.1 * jax.random.normal(ks[8], (DEPTH, FOX_HEADS), f32),
        "gla_alpha_w2": nrm(ks[9], (DEPTH, GLA_GATE_RANK, GLA_KW), GLA_GATE_RANK ** -0.5),
        "gla_alpha_b": nrm(ks[10], (DEPTH, GLA_KW), 0.1),
        "gla_norm_g": gain(ks[11], (DEPTH, GLA_DV)),
        "w_gate": nrm(ks[12], (DEPTH, D, 2 * D), D ** -0.5),
        "w_proj_fox": nrm(ks[13], (DEPTH, FOX_WIDTH, D), FOX_WIDTH ** -0.5),
        "w_proj_gla": nrm(ks[14], (DEPTH, GLA_VW, D), GLA_VW ** -0.5),
        "w_out": nrm(ks[15], (DEPTH, D, D), D ** -0.5),
        "norm2_g": gain(ks[16], (DEPTH, D)),
        "ffn2_w1": nrm(ks[17], (DEPTH, D, D_FF), D ** -0.5),
        "ffn2_w3": nrm(ks[18], (DEPTH, D, D_FF), D ** -0.5),
        "ffn2_w2": nrm(ks[19], (DEPTH, D_FF, D), D_FF ** -0.5),
        "norm_final_g": gain(ks[20], (D,)),
    }


def reference(x, meta_tokens, norm1_g, ffn1_w1, ffn1_w3, ffn1_w2, norm_mix_g, w_in,
              fox_f_bias, gla_alpha_w2, gla_alpha_b, gla_norm_g, w_gate, w_proj_fox,
              w_proj_gla, w_out, norm2_g, ffn2_w1, ffn2_w3, ffn2_w2, norm_final_g):
    b = x.shape[0]
    meta = jnp.broadcast_to(meta_tokens[None].astype(x.dtype), (b, N_META, D_MODEL))
    h = jnp.concatenate([meta, x], axis=1)
    l = h.shape[1]

    for i in range(DEPTH):
        h = h + 0.5 * _swiglu(_rmsnorm(h, norm1_g[i]), ffn1_w1[i], ffn1_w3[i], ffn1_w2[i])

        n = _rmsnorm(h, norm_mix_g[i])
        p = n @ w_in[i]
        qa, ka, va, fa, qb, kb, vb, rb, ab = _split_cols(p, IN_SIZES)

        o_a = _fox_attention(
            qa.reshape(b, l, FOX_HEADS, FOX_HEAD_DIM),
            ka.reshape(b, l, FOX_HEADS, FOX_HEAD_DIM),
            va.reshape(b, l, FOX_HEADS, FOX_HEAD_DIM),
            fa + fox_f_bias[i])
        o_a = o_a.reshape(b, l, FOX_WIDTH)

        log_alpha = jax.nn.log_sigmoid(
            (ab @ gla_alpha_w2[i] + gla_alpha_b[i]).astype(jnp.float32)) / GLA_GATE_TAU
        o_b = _gla_chunk_causal(
            (qb * (GLA_DK ** -0.5)).reshape(b, l, GLA_HEADS, GLA_DK),
            kb.reshape(b, l, GLA_HEADS, GLA_DK),
            vb.reshape(b, l, GLA_HEADS, GLA_DV),
            log_alpha.reshape(b, l, GLA_HEADS, GLA_DK))
        o_b = _rmsnorm(o_b, gla_norm_g[i]).reshape(b, l, GLA_VW) * jax.nn.silu(rb)

        g_a, g_b = jnp.split(jax.nn.sigmoid(n @ w_gate[i]), 2, axis=-1)
        y = g_a * (o_a @ w_proj_fox[i]) + g_b * (o_b @ w_proj_gla[i])
        h = h + y @ w_out[i]

        h = h + 0.5 * _swiglu(_rmsnorm(h, norm2_g[i]), ffn2_w1[i], ffn2_w3[i], ffn2_w2[i])

    h = _rmsnorm(h, norm_final_g)
    return h[:, N_META:]
```

```cpp
#include <hip/hip_runtime.h>
#include <cstdio>
#include <cstdint>

#ifndef MK_N_LAUNCHES
#define MK_N_LAUNCHES 1
#endif

namespace pg8 {
#define PG8_LAS __attribute__((address_space(3)))
typedef unsigned short bf16_t;
typedef short bf16x8 __attribute__((ext_vector_type(8)));
typedef float f32x4 __attribute__((ext_vector_type(4)));
typedef unsigned u32x4 __attribute__((ext_vector_type(4)));
typedef unsigned u32x2 __attribute__((ext_vector_type(2)));
constexpr int BM = 256, BK = 64, HALF = 128, HTB = HALF * BK * 2  , STAGE_BYTES = 8 * HTB, NXCD = 8, WGM = 8;

__host__ __device__ __forceinline__ int lds_byte(int r, int c) { const int st = (r >> 4) * 2 + (c >> 5), rr = r & 15, cc = c & 31, ob = rr * 64 + cc * 2; return st * 1024 + (ob ^ (((ob >> 9) & 1) << 5)); }
__host__ __device__ __forceinline__ void stage_rc(int b, int& R, int& C) { const int st = b / 1024, sb = b % 1024, swz = sb ^ (((sb >> 9) & 1) << 5); R = (st >> 1) * 16 + swz / 64; C = (st & 1) * 32 + (swz % 64) / 2; }
__host__ __device__ __forceinline__ int perm32(int rho) { const int n = rho >> 4, i = rho & 15; return 8 * (i >> 2) + 4 * n + (i & 3); }

struct Unit { int arow, brow, pn; };
struct Gemm { const bf16_t* A; const bf16_t* Bt; int lda, ldb, K; };

typedef int i32x4 __attribute__((ext_vector_type(4)));
template <bool I8> struct AccSel { typedef f32x4 T; };
template <> struct AccSel<true> { typedef i32x4 T; };
struct GridOrder {
    int nM, nN, nwg, G, c, arow0, brow0;
    __device__ void init(int nM_, int nN_, int G_, int c_, int arow0_, int brow0_) { nM = nM_; nN = nN_; nwg = nM * nN; G = G_; c = c_; arow0 = arow0_; brow0 = brow0_; }
    __device__ bool next(int i, Unit& u) const {
        const long L = (long)i * G + c; if (L >= nwg) return false;
        int wgid = (int)L; { const int q = nwg / NXCD, r = nwg % NXCD, xcd = wgid % NXCD, off = wgid / NXCD; wgid = (xcd < r ? xcd * (q + 1) : r * (q + 1) + (xcd - r) * q) + off; }
        const int nig = WGM * nN, gid = wgid / nig, fm = gid * WGM, gsz = (nM - fm) < WGM ? (nM - fm) : WGM;
        const int pm = fm + ((wgid % nig) % gsz), pn = (wgid % nig) / gsz;
        u.arow = arow0 + pm * BM; u.brow = brow0 + pn * BM; u.pn = pn; return true;
    }
};

__device__ __forceinline__ unsigned cvt_pk_bf16(float lo, float hi) { unsigned r; asm volatile("v_cvt_pk_bf16_f32 %0, %1, %2" : "=v"(r) : "v"(lo), "v"(hi)); return r; }

template <class Epi, class Sched, bool ALIGN_EPI = true, bool MHALF = false, bool I8 = false>
__device__ __forceinline__ void gemm_phase(PG8_LAS unsigned char* lds, const Gemm g, const Sched& S, const Epi& E) {
    const int tid = threadIdx.x, wid = __builtin_amdgcn_readfirstlane(tid >> 6), lane = tid & 63, wr = wid >> 2, wc = wid & 3, fr = lane & 15, fq = lane >> 4;
    const int K = g.K, nt = K / BK;
    unsigned voffA[2], voffB[2];
#pragma unroll
    for (int i = 0; i < 2; ++i) { int R, C; stage_rc(tid * 16 + i * 8192, R, C); const int Rb = (R & ~31) + perm32(R & 31);
        voffA[i] = (unsigned)(R * g.lda + C) * 2u; voffB[i] = (unsigned)(Rb * g.ldb + C) * 2u; }
    const size_t kstep = (size_t)(BK * 2);
    const size_t hstepA = (size_t)HALF * g.lda * 2, hstepB = (size_t)HALF * g.ldb * 2;
    const unsigned ldsw = (unsigned)wid * 1024u;
    const int aoff = lds_byte(wr * 64 + fr, fq * 8), boff = lds_byte(wc * 32 + fr, fq * 8);
#define PG8_SA(b, h) (((b) * 2 + (h)) * HTB)
#define PG8_SB(b, h) ((4 + (b) * 2 + (h)) * HTB)
#define PG8_STAGE(bufoff, gbase, voff) do { _Pragma("unroll") for (int _i = 0; _i < 2; ++_i) \
        __builtin_amdgcn_global_load_lds((const unsigned*)((const char*)(gbase) + (voff)[_i]), (PG8_LAS unsigned*)(lds + (bufoff) + ldsw + _i * 8192), 16, 0, 0); } while (0)
#define PG8_LDA(dst, b, h) do { _Pragma("unroll") for (int m = 0; m < 4; ++m) _Pragma("unroll") for (int k = 0; k < 2; ++k) dst[m][k] = *(const PG8_LAS bf16x8*)(lds + PG8_SA(b, h) + aoff + m * 2048 + k * 1024); } while (0)
#define PG8_LDB(dst, b, h) do { _Pragma("unroll") for (int n = 0; n < 2; ++n) _Pragma("unroll") for (int k = 0; k < 2; ++k) dst[n][k] = *(const PG8_LAS bf16x8*)(lds + PG8_SB(b, h) + boff + n * 2048 + k * 1024); } while (0)
#define PG8_MMA(ai, bj, At, Bt) do { __builtin_amdgcn_s_setprio(1); _Pragma("unroll") for (int m = 0; m < 4; ++m) _Pragma("unroll") for (int n = 0; n < 2; ++n) _Pragma("unroll") for (int k = 0; k < 2; ++k) \
        { if constexpr (I8) acc[ai][bj][m][n] = __builtin_amdgcn_mfma_i32_16x16x64_i8(__builtin_bit_cast(i32x4, Bt[n][k]), __builtin_bit_cast(i32x4, At[m][k]), acc[ai][bj][m][n], 0, 0, 0); \
          else acc[ai][bj][m][n] = __builtin_amdgcn_mfma_f32_16x16x32_bf16(Bt[n][k], At[m][k], acc[ai][bj][m][n], 0, 0, 0); } __builtin_amdgcn_s_setprio(0); } while (0)
#define PG8_WAIT_V(n) asm volatile("s_waitcnt vmcnt(" #n ")" ::: "memory")
#define PG8_WAIT_L(n) asm volatile("s_waitcnt lgkmcnt(" #n ")" ::: "memory")
#define PG8_BAR __builtin_amdgcn_s_barrier()
#define PG8_SCHED __builtin_amdgcn_sched_barrier(0)
    Unit cur, nxt; int ui = 0;
    if (!S.next(0, cur)) return;
    typename AccSel<I8>::T acc[2][2][4][2];
#pragma unroll
    for (int a = 0; a < 2; ++a)
#pragma unroll
        for (int b = 0; b < 2; ++b)
#pragma unroll
            for (int m = 0; m < 4; ++m)
#pragma unroll
                for (int n = 0; n < 2; ++n) acc[a][b][m][n] = (typename AccSel<I8>::T){0, 0, 0, 0};
    bf16x8 At[4][2], B0[2][2], B1[2][2];
    const char* cA = (const char*)g.A + (size_t)cur.arow * g.lda * 2; const char* cB = (const char*)g.Bt + (size_t)cur.brow * g.ldb * 2;
    PG8_STAGE(PG8_SB(0, 0), cB, voffB); PG8_STAGE(PG8_SB(0, 1), cB + hstepB, voffB); PG8_STAGE(PG8_SA(0, 0), cA, voffA); PG8_STAGE(PG8_SA(0, 1), cA + hstepA, voffA);
    if (wr == 1) PG8_BAR;
    PG8_WAIT_V(2); PG8_BAR;
    PG8_STAGE(PG8_SB(1, 0), cB + kstep, voffB); PG8_STAGE(PG8_SA(1, 0), cA + kstep, voffA); PG8_STAGE(PG8_SB(1, 1), cB + hstepB + kstep, voffB);
    PG8_WAIT_V(6); PG8_BAR;
    for (;;) {
        const bool has_next = S.next(ui + 1, nxt);
        const char* nA = has_next ? (const char*)g.A + (size_t)nxt.arow * g.lda * 2 : cA; const char* nB = has_next ? (const char*)g.Bt + (size_t)nxt.brow * g.ldb * 2 : cB;
        for (int t = 0; t < nt; t += 2) {
            const bool last = (t == nt - 2);
            const char* a1 = cA + (size_t)(t + 1) * kstep;
            const char* a2 = last ? nA : cA + (size_t)(t + 2) * kstep; const char* b2 = last ? nB : cB + (size_t)(t + 2) * kstep;
            const char* a3 = a2 + kstep; const char* b3 = b2 + kstep;
            PG8_LDB(B0, 0, 0); PG8_LDB(B1, 0, 1); PG8_SCHED; PG8_LDA(At, 0, 0); PG8_STAGE(PG8_SA(1, 1), a1 + hstepA, voffA);
            PG8_WAIT_V(8); PG8_WAIT_L(0); PG8_BAR; PG8_MMA(0, 0, At, B0); PG8_MMA(0, 1, At, B1); PG8_BAR; PG8_SCHED;
            if (!MHALF) PG8_LDA(At, 0, 1); PG8_STAGE(PG8_SB(0, 0), b2, voffB); PG8_STAGE(PG8_SB(0, 1), b2 + hstepB, voffB); PG8_STAGE(PG8_SA(0, 0), a2, voffA);
            PG8_WAIT_V(8); PG8_WAIT_L(0); PG8_BAR; if (!MHALF) { PG8_MMA(1, 0, At, B0); PG8_MMA(1, 1, At, B1); } PG8_BAR; PG8_SCHED;
            PG8_LDB(B0, 1, 0); PG8_LDB(B1, 1, 1); PG8_SCHED; PG8_LDA(At, 1, 0); PG8_STAGE(PG8_SA(0, 1), a2 + hstepA, voffA);
            PG8_WAIT_V(8); PG8_WAIT_L(0); PG8_BAR; PG8_MMA(0, 0, At, B0); PG8_MMA(0, 1, At, B1); PG8_BAR; PG8_SCHED;
            if (!MHALF) PG8_LDA(At, 1, 1); PG8_STAGE(PG8_SB(1, 0), b3, voffB); PG8_STAGE(PG8_SB(1, 1), b3 + hstepB, voffB); PG8_STAGE(PG8_SA(1, 0), a3, voffA);
            PG8_WAIT_V(8); PG8_WAIT_L(0); PG8_BAR; if (!MHALF) { PG8_MMA(1, 0, At, B0); PG8_MMA(1, 1, At, B1); } PG8_BAR; PG8_SCHED;
        }
        if constexpr (ALIGN_EPI) { if (wr == 0) PG8_BAR; }
        if constexpr (I8) { f32x4 accf[2][2][4][2];
#pragma unroll
            for (int a = 0; a < 2; ++a)
#pragma unroll
                for (int b = 0; b < 2; ++b)
#pragma unroll
                    for (int m = 0; m < 4; ++m)
#pragma unroll
                        for (int n = 0; n < 2; ++n) accf[a][b][m][n] = __builtin_convertvector(acc[a][b][m][n], f32x4);
            E(accf, cur, wr, wc, fr, fq); }
        else E(acc, cur, wr, wc, fr, fq);
        if (!has_next) break;
#pragma unroll
        for (int a = 0; a < 2; ++a)
#pragma unroll
            for (int b = 0; b < 2; ++b)
#pragma unroll
                for (int m = 0; m < 4; ++m)
#pragma unroll
                    for (int n = 0; n < 2; ++n) acc[a][b][m][n] = (typename AccSel<I8>::T){0, 0, 0, 0};
        cur = nxt; cA = nA; cB = nB; ++ui;
        if constexpr (ALIGN_EPI) { if (wr == 1) PG8_BAR; }
    }
    PG8_WAIT_V(0);
    if constexpr (!ALIGN_EPI) { if (wr == 0) PG8_BAR; }
    PG8_BAR;
#undef PG8_SA
#undef PG8_SB
#undef PG8_STAGE
#undef PG8_LDA
#undef PG8_LDB
#undef PG8_MMA
#undef PG8_WAIT_V
#undef PG8_WAIT_L
#undef PG8_BAR
#undef PG8_SCHED
}
}

namespace fox {
typedef unsigned short bf16;
typedef short bf16x8 __attribute__((ext_vector_type(8)));
typedef short s16x4 __attribute__((ext_vector_type(4)));
typedef float f32x16 __attribute__((ext_vector_type(16)));
typedef float f32x4 __attribute__((ext_vector_type(4)));
typedef unsigned u32x4 __attribute__((ext_vector_type(4)));
constexpr int D = 128;
constexpr float SCALE = 0.08838834764831845f;
constexpr float THR = 8.f;
constexpr int NW = 8, QBLK = 32, KVBLK = 64, QB = NW * QBLK;
constexpr int SHM_V = KVBLK * D * 2, SHM_K = KVBLK * D * 2;
constexpr int LDS_CORE = 2 * SHM_V + 2 * SHM_K + NW * 64 * 4;
constexpr int CB_OFF = 69632;
constexpr int OSTRIDE = 4096;

#define KSWZ(row, colB) ((row) * 256 + ((colB) ^ (((row) & 7) << 4)))
#define SBAR() __builtin_amdgcn_sched_barrier(0)
__device__ __forceinline__ int v_st(int k, int c) { const int kk = (k & ~0xC) | ((k & 4) << 1) | ((k & 8) >> 1); return ((kk >> 3) * 4 + (c >> 5)) * 512 + ((kk & 7) * 32 + (c & 31)) * 2; }
__device__ __forceinline__ int v_rd_base(int lane) { return ((lane & 3) << 3) | (((lane >> 2) & 3) << 6) | (((lane >> 4) & 1) << 5) | (((lane >> 5) & 1) << 8); }
constexpr int v_rd_off(int d0, int ks, int half) { return d0 * 512 + ks * 4096 + half * 2048; }
__device__ __forceinline__ int crow(int r, int hi) { return (r & 3) + 8 * (r >> 2) + 4 * hi; }
__device__ __forceinline__ unsigned cvtpk(float lo, float hi) { unsigned r; asm volatile("v_cvt_pk_bf16_f32 %0, %1, %2" : "=v"(r) : "v"(lo), "v"(hi)); return r; }
__device__ __forceinline__ bf16x8 load8(const bf16* p) { return *reinterpret_cast<const bf16x8*>(p); }
__device__ __forceinline__ void mask_tile(f32x16& p0, f32x16& p1, int dq) {
    const float NEG = -__builtin_inff();
#pragma unroll
    for (int r = 0; r < 16; ++r) {
        const int c = (r & 3) + 8 * (r >> 2);
        if (dq - c < 0) p0[r] = NEG;
        if (dq - c - 32 < 0) p1[r] = NEG;
    }
}
__device__ __forceinline__ void partialSM(f32x16& p0, f32x16& p1, float& m_reg, float& mn, float& alpha) {
    float pmax = p0[0];
#pragma unroll
    for (int r = 1; r < 16; ++r) pmax = fmaxf(pmax, p0[r]);
#pragma unroll
    for (int r = 0; r < 16; ++r) pmax = fmaxf(pmax, p1[r]);
    { auto rr = __builtin_amdgcn_permlane32_swap(__float_as_uint(pmax), __float_as_uint(pmax), false, false);
      pmax = fmaxf(__uint_as_float(rr[0]), __uint_as_float(rr[1])); }
    constexpr float C2 = 1.4426950408889634f * SCALE;
    if (__builtin_expect(__all((pmax - m_reg) * SCALE <= THR), 1)) { mn = m_reg; alpha = 1.f; }
    else { mn = fmaxf(m_reg, pmax); alpha = __builtin_amdgcn_exp2f((m_reg - mn) * C2); m_reg = mn; }
    const float mnL = -mn * C2;
#pragma unroll
    for (int r = 0; r < 16; ++r) p0[r] = fmaf(p0[r], C2, mnL);
#pragma unroll
    for (int r = 0; r < 16; ++r) p1[r] = fmaf(p1[r], C2, mnL);
#pragma unroll
    for (int r = 0; r < 16; ++r) p0[r] = __builtin_amdgcn_exp2f(p0[r]);
}
__device__ __forceinline__ void finishSM(f32x16& p0, f32x16& p1, float alpha, float& l_reg, bf16x8& pa0, bf16x8& pa1, bf16x8& pa2, bf16x8& pa3) {
#pragma unroll
    for (int r = 0; r < 16; ++r) p1[r] = __builtin_amdgcn_exp2f(p1[r]);
    float ps = 0;
#pragma unroll
    for (int r = 0; r < 16; ++r) ps += p0[r];
#pragma unroll
    for (int r = 0; r < 16; ++r) ps += p1[r];
    { auto rr = __builtin_amdgcn_permlane32_swap(__float_as_uint(ps), __float_as_uint(ps), false, false);
      ps = __uint_as_float(rr[0]) + __uint_as_float(rr[1]); }
    l_reg = l_reg * alpha + ps;
#define PK4(P, B_, OUT) do { unsigned a0 = cvtpk(P[B_+0], P[B_+1]), a1 = cvtpk(P[B_+2], P[B_+3]);                          \
        unsigned b0 = cvtpk(P[B_+4], P[B_+5]), b1 = cvtpk(P[B_+6], P[B_+7]);                                             \
        auto r0 = __builtin_amdgcn_permlane32_swap(a0, b0, false, false); auto r1 = __builtin_amdgcn_permlane32_swap(a1, b1, false, false); \
        u32x4 w = {r0[0], r1[0], r0[1], r1[1]}; OUT = *reinterpret_cast<bf16x8*>(&w); } while (0)
    PK4(p0, 0, pa0); PK4(p0, 8, pa1); PK4(p1, 0, pa2); PK4(p1, 8, pa3);
#undef PK4
}
template <int KB>
__device__ __forceinline__ void qkt(f32x16& p0, f32x16& p1, const char* K_lds, int r32, int hi, const bf16x8* qr, const float* cbt) {
#pragma unroll
    for (int g = 0; g < 4; ++g) { const f32x4 a = *reinterpret_cast<const f32x4*>(cbt + 8 * g), b = *reinterpret_cast<const f32x4*>(cbt + 32 + 8 * g);
        p0[4 * g] = a[0]; p0[4 * g + 1] = a[1]; p0[4 * g + 2] = a[2]; p0[4 * g + 3] = a[3]; p1[4 * g] = b[0]; p1[4 * g + 1] = b[1]; p1[4 * g + 2] = b[2]; p1[4 * g + 3] = b[3]; }
    const char* kb[4];
#pragma unroll
    for (int dd = 0; dd < 4; ++dd) kb[dd] = K_lds + KB * SHM_K + KSWZ(r32, (dd * 16 + hi * 8) * 2);
#pragma unroll
    for (int d0 = 0; d0 < 8; ++d0) { const char* a = kb[d0 & 3] + (d0 >> 2) * 128;
        bf16x8 b0 = *reinterpret_cast<const bf16x8*>(a);
        bf16x8 b1 = *reinterpret_cast<const bf16x8*>(a + 32 * 256);
        p0 = __builtin_amdgcn_mfma_f32_32x32x16_bf16(b0, qr[d0], p0, 0, 0, 0);
        p1 = __builtin_amdgcn_mfma_f32_32x32x16_bf16(b1, qr[d0], p1, 0, 0, 0); }
}
template <int VB>
__device__ __forceinline__ void pv_tile(f32x16* o, int vb0, bf16x8 pa0, bf16x8 pa1, bf16x8 pa2, bf16x8 pa3) {
#define TRRD(dst, off) asm volatile("ds_read_b64_tr_b16 %0, %1 offset:%2" : "=&v"(dst) : "v"(vb0), "i"(off) : "memory")
#define PV_D0(d0) do { s16x4 l0, l1, l2, l3, h0, h1, h2, h3; constexpr int b_ = VB * SHM_V + v_rd_off(d0, 0, 0);   \
        TRRD(l0, b_); TRRD(h0, b_ + 2048); TRRD(l1, b_ + 4096); TRRD(h1, b_ + 6144); TRRD(l2, b_ + 8192); TRRD(h2, b_ + 10240); TRRD(l3, b_ + 12288); TRRD(h3, b_ + 14336); \
        asm volatile("s_waitcnt lgkmcnt(0)" ::: "memory"); SBAR();   \
        o[d0] = __builtin_amdgcn_mfma_f32_32x32x16_bf16(pa0, (bf16x8){l0[0], l0[1], l0[2], l0[3], h0[0], h0[1], h0[2], h0[3]}, o[d0], 0, 0, 0);   \
        o[d0] = __builtin_amdgcn_mfma_f32_32x32x16_bf16(pa1, (bf16x8){l1[0], l1[1], l1[2], l1[3], h1[0], h1[1], h1[2], h1[3]}, o[d0], 0, 0, 0);   \
        o[d0] = __builtin_amdgcn_mfma_f32_32x32x16_bf16(pa2, (bf16x8){l2[0], l2[1], l2[2], l2[3], h2[0], h2[1], h2[2], h2[3]}, o[d0], 0, 0, 0);   \
        o[d0] = __builtin_amdgcn_mfma_f32_32x32x16_bf16(pa3, (bf16x8){l3[0], l3[1], l3[2], l3[3], h3[0], h3[1], h3[2], h3[3]}, o[d0], 0, 0, 0); } while (0)
    PV_D0(0); PV_D0(1); PV_D0(2); PV_D0(3);
#undef PV_D0
#undef TRRD
}

struct BlockRef { const bf16* Q; const bf16* K; const bf16* V; bf16* O; int P0; int jlo; };
struct Seam { bf16x8 qr[8]; bf16x8 st_v0, st_v1, st_k0, st_k1; };
#define ROW(p, k0, rr) ((p) + (size_t)((k0) + (rr)) * D + sc)
#define VMW() asm volatile("s_waitcnt vmcnt(0)" ::: "memory")
#define VMWN(n) asm volatile("s_waitcnt vmcnt(%0)" :: "i"(n) : "memory")
#define SLOAD_H(Kp, Vp, k0) do { S.st_v0 = load8(ROW(Vp, k0, sr)); S.st_v1 = load8(ROW(Vp, k0, 32 + sr));              \
                         S.st_k0 = load8(ROW(Kp, k0, sr)); S.st_k1 = load8(ROW(Kp, k0, 32 + sr)); } while (0)
#define SWRITE_HK(bf) do { *(bf16x8*)(K_lds + (bf) * SHM_K + kws) = S.st_k0; *(bf16x8*)(K_lds + (bf) * SHM_K + kws + 32 * 256) = S.st_k1; } while (0)
#define SWRITE_HV(bf) do { *(bf16x8*)(V_lds + (bf) * SHM_V + vst0) = S.st_v0; *(bf16x8*)(V_lds + (bf) * SHM_V + vst1) = S.st_v1; } while (0)
#define SWRITE_H(bf) do { SWRITE_HV(bf); SWRITE_HK(bf); } while (0)
__device__ __forceinline__ void fox_prime(const BlockRef& cur, char* lds, Seam& S) {
    const int tid = threadIdx.x, wid = __builtin_amdgcn_readfirstlane(tid >> 6), lane = tid & 63, r32 = lane & 31, hi = lane >> 5;
    const int sr = tid >> 4, sc = (tid & 15) * 8, kws = KSWZ(sr, sc * 2); char* K_lds = lds + 2 * SHM_V;
#pragma unroll
    for (int d0 = 0; d0 < 8; ++d0) S.qr[d0] = load8(cur.Q + (size_t)(wid * QBLK + r32) * D + d0 * 16 + hi * 8);
    SLOAD_H(cur.K, cur.V, cur.P0 + QB - KVBLK); VMW(); SWRITE_HK(0);
    __syncthreads();
}
__device__ __forceinline__ void fox_block(const BlockRef& cur, const BlockRef& nxt, char* lds, Seam& S) {
    const int tid = threadIdx.x, wid = __builtin_amdgcn_readfirstlane(tid >> 6), lane = tid & 63, r32 = lane & 31, hi = lane >> 5;
    const int NTK = (cur.P0 + QB - 1) / KVBLK + 1, NT = NTK - cur.jlo;
    const int qlo = cur.P0 + wid * QBLK, qm = qlo + r32 - 4 * hi;
    char* V_lds = lds; char* K_lds = lds + 2 * SHM_V;
    float* ws = (float*)(lds + 2 * SHM_V + 2 * SHM_K) + wid * 64; float* li_l = ws, * al_l = ws + 32;
    int hi_o; asm volatile("v_mov_b32 %0, %1" : "=v"(hi_o) : "v"(hi));
    const float* cbl = (const float*)(lds + CB_OFF) + 4 * hi_o;
    float m_reg = -1e30f, l_reg = 0; f32x16 o[4] = {};
    const int sr = tid >> 4, sc = (tid & 15) * 8, vst0 = v_st(sr, sc), vst1 = v_st(32 + sr, sc), kws = KSWZ(sr, sc * 2);
    const int vb0 = (int)(uintptr_t)V_lds + v_rd_base(lane);
    const bf16* Kh = cur.K; const bf16* Vh = cur.V;
#define RESC(a) do { if (__any((a) < 1.f)) { if (hi == 0) al_l[r32] = (a); asm volatile("s_waitcnt lgkmcnt(0)" ::: "memory");              \
                     for (int d_ = 0; d_ < 4; ++d_) for (int r = 0; r < 16; ++r) o[d_][r] *= al_l[crow(r, hi)]; } } while (0)
#define KBASE(t) ((NTK - 1 - (t)) * KVBLK)
#define MASKT(P0_, P1_, t) do { const int kb_ = KBASE(t); if (kb_ + KVBLK - 1 > qlo) mask_tile(P0_, P1_, qm - kb_); } while (0)
#define SEAM_K0() do { VMWN(8); SWRITE_HK(0); SBAR(); } while (0)
    f32x16 pA0, pA1, pB0, pB1; float mnA, mnB, alA, alB; bf16x8 pa0, pa1, pa2, pa3;
    SWRITE_HV(0); SBAR();
    if (NT > 1) SLOAD_H(Kh, Vh, KBASE(1));
    SBAR(); qkt<0>(pA0, pA1, K_lds, r32, hi, S.qr, cbl + KBASE(0));
    MASKT(pA0, pA1, 0); partialSM(pA0, pA1, m_reg, mnA, alA);
    if (NT > 1) { VMW(); SWRITE_H(1); }
    __syncthreads();
#define HALF_STEP(PX0, PX1, mnX, alX, PY0, PY1, alY, t, KB, VB, SB) do {                                                      \
        SBAR(); qkt<KB>(PX0, PX1, K_lds, r32, hi, S.qr, cbl + KBASE(t));                                                      \
        finishSM(PY0, PY1, alY, l_reg, pa0, pa1, pa2, pa3); SBAR();                                                           \
        if ((t) + 1 < NT) { SLOAD_H(Kh, Vh, KBASE((t) + 1)); SBAR(); }                                                        \
        pv_tile<VB>(o, vb0, pa0, pa1, pa2, pa3); MASKT(PX0, PX1, (t)); partialSM(PX0, PX1, m_reg, mnX, alX);                  \
        __syncthreads();                                                                                                      \
        if ((t) + 1 < NT) { VMW(); SWRITE_H(SB); }                                                                            \
        RESC(alX); __syncthreads(); } while (0)
    for (int t = 1; t + 1 < NT; t += 2) {
        HALF_STEP(pB0, pB1, mnB, alB, pA0, pA1, alA, t, 1, 0, 0);
        HALF_STEP(pA0, pA1, mnA, alA, pB0, pB1, alB, t + 1, 0, 1, 1);
    }
    const bool even = (NT & 1) == 0;
    if (even) { SBAR(); qkt<1>(pB0, pB1, K_lds, r32, hi, S.qr, cbl + KBASE(NT - 1)); SBAR(); }
    SLOAD_H(nxt.K, nxt.V, nxt.P0 + QB - KVBLK); SBAR();
#pragma unroll
    for (int d0 = 0; d0 < 8; ++d0) S.qr[d0] = load8(nxt.Q + (size_t)(wid * QBLK + r32) * D + d0 * 16 + hi * 8);
    SBAR();
    finishSM(pA0, pA1, alA, l_reg, pa0, pa1, pa2, pa3); SBAR();
    pv_tile<0>(o, vb0, pa0, pa1, pa2, pa3);
    if (even) { MASKT(pB0, pB1, NT - 1); partialSM(pB0, pB1, m_reg, mnB, alB); __syncthreads(); RESC(alB);
        finishSM(pB0, pB1, alB, l_reg, pa0, pa1, pa2, pa3); SBAR(); pv_tile<1>(o, vb0, pa0, pa1, pa2, pa3); }
    SBAR(); SEAM_K0();
    if (hi == 0) li_l[r32] = l_reg; asm volatile("s_waitcnt lgkmcnt(0)" ::: "memory");
    float rli[16];
#pragma unroll
    for (int r = 0; r < 16; ++r) rli[r] = __builtin_amdgcn_rcpf(li_l[crow(r, hi)]);
    int anchor; asm volatile("v_mov_b32 %0, 0" : "=v"(anchor));
    char* Ow = (char*)(cur.O + (size_t)(wid * QBLK) * OSTRIDE) + (unsigned)(anchor + ((4 * hi) * OSTRIDE + r32) * 2);
#pragma unroll
    for (int r = 0; r < 16; ++r) { const int orow0 = (r & 3) + 8 * (r >> 2);
#pragma unroll
        for (int d0 = 0; d0 < 4; ++d0) { const float v = o[d0][r] * rli[r];
            const float vn = __shfl_xor(v, 1);
            if ((r32 & 1) == 0) *(unsigned*)(Ow + (orow0 * OSTRIDE + d0 * 32) * 2) = cvtpk(v, vn); } }
    __syncthreads();
#undef RESC
#undef KBASE
#undef MASKT
#undef SEAM_K0
#undef HALF_STEP
}
#undef ROW
#undef VMW
#undef VMWN
#undef SLOAD_H
#undef SWRITE_HK
#undef SWRITE_HV
#undef SWRITE_H
}

constexpr int NWAVES = 8;
constexpr int DM = 4096, DFF = 11008, SEQ = 8192, NMETA = 16, L = SEQ + NMETA  , LP = 8448  ;
constexpr int FOXH = 16, FOXD = 128, FOXW = 2048;
constexpr int GLAH = 4, GDK = 256, GDV = 512, GKW = 1024, GVW = 2048, GRANK = 16, NCHUNK = 129, CHUNK = 64, PADL = 48;
constexpr int DIN = 12320;
constexpr float EPS = 1e-6f;
constexpr int WIN_ROWS = 49 * 256 + 32 * 256;
constexpr int WIN_SMALL = 12288, WIN_GATE = 12544;

constexpr size_t MiB = 1u << 20;
constexpr size_t WS_CTL = 0, CTL_ZERO_BYTES = 1 * MiB;
constexpr size_t WS_W1A = 1 * MiB, WS_W1B = 173 * MiB, WS_WIN = 259 * MiB, WS_WP = 421 * MiB, WS_WO = 453 * MiB, WS_W2A = 485 * MiB, WS_W2B = 657 * MiB;
constexpr size_t WS_ABUF = 743 * MiB, WS_HID = 809 * MiB, WS_H = 987 * MiB, WS_GA = 1119 * MiB, WS_GB = 1185 * MiB, WS_OAB = 1251 * MiB;
constexpr size_t WS_KDT = 1317 * MiB, WS_VT = 1334 * MiB, WS_GG = 1367 * MiB, WS_SM = 1368 * MiB  , WS_CB = 1370 * MiB, WS_END = 1371 * MiB;
constexpr size_t WS_FQ = 1 * MiB, WS_FK = 34 * MiB, WS_FV = 67 * MiB, WS_GQ = 100 * MiB, WS_GK = 117 * MiB, WS_GV = 134 * MiB, WS_GR = 167 * MiB;
constexpr size_t WS_A8 = 1053 * MiB  , WS_WG8 = WS_WIN + (size_t)WIN_GATE * DM * 2  ;
constexpr size_t WS_OPART = WS_HID  , WS_Y = WS_HID, WS_YBF = 1 * MiB;
static_assert((size_t)WIN_ROWS * DM * 2 == 162 * MiB && (size_t)22016 * DM * 2 == 172 * MiB && (size_t)LP * DM * 2 == 66 * MiB && (size_t)LP * DFF * 2 <= 178 * MiB && (size_t)LP * DM * 4 == 132 * MiB, "ws map");
static_assert((size_t)FOXH * LP * FOXD * 2 == 33 * MiB && (size_t)LP * GKW * 2 <= 17 * MiB && (size_t)LP * GVW * 2 == 33 * MiB && (size_t)GLAH * NCHUNK * GDK * CHUNK * 2 <= 17 * MiB && (size_t)GLAH * NCHUNK * GDV * CHUNK * 2 <= 33 * MiB, "ws map 2");
constexpr int CW_TMO = 0, CW_CODE = 1, CW_BAR = 4096, CW_QUEUE = 8192, CW_PANEL = 10240  , CW_PANEL9 = 10752  , CW_QKN = 12288  , CW_SS2 = 16384, CW_SS3 = 16384 + 2 * 8704, CW_SS4 = 16384 + 4 * 8704;
constexpr int WCH_G = 0, WCH_F2 = 8192, WCH_F1 = 8192 + 22016, WCH_N = WCH_F1 + 22016;
constexpr int CW_WMAX = CW_SS4 + 2 * 8704  , CW_AMAX3 = CW_WMAX + WCH_N  ,
    CW_WSS = CW_AMAX3 + 8704  ;
constexpr size_t WS_WCLIP = 1087 * MiB;
constexpr size_t WS_RS1 = 1088 * MiB, WS_RS2 = WS_RS1 + LP * 4, WS_RS3 = WS_RS2 + LP * 4;
static_assert(CW_SS4 + 2 * 8704 <= CW_WMAX && (CW_WSS & 1) == 0 && (CW_WSS + 2 * WCH_N) * 4 <= (int)CTL_ZERO_BYTES, "CTL map");
static_assert((CW_SS4 + 2 * 8704) * 4 <= (int)CTL_ZERO_BYTES, "CTL words inside the memset region");

constexpr int RING_OFF = 0, RING_BYTES = 131072;
constexpr int LDSCTL_OFF = RING_BYTES, MISC_OFF = LDSCTL_OFF + 320;
constexpr int LDS_BYTES = 147456;
static_assert(MISC_OFF + 128 <= LDS_BYTES && fox::CB_OFF + LP * 4 <= RING_BYTES, "LDS map");

#define GAS __attribute__((address_space(1)))
#define LAS __attribute__((address_space(3)))
typedef unsigned short bf16;
typedef unsigned v4u __attribute__((ext_vector_type(4)));
typedef unsigned v2u __attribute__((ext_vector_type(2)));
typedef float f32x4 __attribute__((ext_vector_type(4)));
typedef float f32x2 __attribute__((ext_vector_type(2)));
typedef float f32x16 __attribute__((ext_vector_type(16)));
typedef short bf16x8 __attribute__((ext_vector_type(8)));
typedef short bf16x4 __attribute__((ext_vector_type(4)));
typedef GAS unsigned gu32;
typedef unsigned long long ssq_t;
constexpr float SSFIX = 4294967296.0f;
#define RLX_AGENT __ATOMIC_RELAXED, __HIP_MEMORY_SCOPE_AGENT
#define LDS_WAIT() asm volatile("s_waitcnt lgkmcnt(0)" ::: "memory")
#define VM_WAIT() asm volatile("s_waitcnt vmcnt(0)" ::: "memory")
typedef __bf16 bf16x2_t __attribute__((ext_vector_type(2)));
__device__ __forceinline__ unsigned pk2(float lo, float hi) { f32x2 v = {lo, hi}; bf16x2_t b = __builtin_convertvector(v, bf16x2_t); return __builtin_bit_cast(unsigned, b); }
__device__ __forceinline__ float bf_lo(unsigned w) { return __uint_as_float(w << 16); }
__device__ __forceinline__ float bf_hi(unsigned w) { return __uint_as_float(w & 0xffff0000u); }
__device__ __forceinline__ float sigmoidf_fast(float x) { return __builtin_amdgcn_rcpf(1.0f + __builtin_amdgcn_exp2f(-1.4426950408889634f * x)); }
__device__ __forceinline__ float siluf_fast(float x) { return x * sigmoidf_fast(x); }
__device__ __forceinline__ float log_sigmoidf_acc(float z) { return fminf(z, 0.f) - log1pf(expf(-fabsf(z))); }
__device__ __forceinline__ float log_sigmoidf_fast(float z) { const float t = __builtin_amdgcn_exp2f(-1.4426950408889634f * fabsf(z)); return fminf(z, 0.f) - 0.6931471805599453f * __builtin_amdgcn_logf(1.0f + t); }
__device__ __forceinline__ float expf_fast(float x) { return __builtin_amdgcn_exp2f(1.4426950408889634f * x); }
__device__ __forceinline__ int lane_id_fresh() { int l; asm volatile("v_mbcnt_lo_u32_b32 %0, -1, 0\n\tv_mbcnt_hi_u32_b32 %0, -1, %0" : "=v"(l)); return l; }
__device__ __forceinline__ float wave_sum(float v) {
#pragma unroll
    for (int o = 1; o < 64; o <<= 1) v += __shfl_xor(v, o);
    return v;
}

#define XB_TMO      128
#define XB_XCNT(j)  (256  + 64 * (j))
#define XB_XSUB(j)  (1280 + 64 * (j))
#define XB_XGEN(j)  (2304 + 64 * (j))
#define XB_TOP      3328
#define XB_TOPGEN   3392
#define XCD_BAR_WORDS 3456
#define XB_SPIN_CAP (1u << 18)
__device__ __forceinline__ unsigned xb_ld(unsigned* p)              { return __hip_atomic_load(p, __ATOMIC_RELAXED, __HIP_MEMORY_SCOPE_AGENT); }
__device__ __forceinline__ unsigned xb_add(unsigned* p, unsigned v) { return __hip_atomic_fetch_add(p, v, __ATOMIC_RELAXED, __HIP_MEMORY_SCOPE_AGENT); }
__device__ __forceinline__ unsigned xb_xcc_id() { return (unsigned)__builtin_amdgcn_s_getreg((3 << 11) | 20) & 0xFu; }
#define XB_SPIN(cond, bar) do { unsigned _sp = 0; while (cond) { __builtin_amdgcn_s_sleep(1); \
    if ((++_sp & 255u) == 0u) { if (xb_ld(&(bar)[XB_TMO])) break; if (_sp > XB_SPIN_CAP) { atomicAdd(&(bar)[XB_TMO], 1u); break; } } } } while (0)
struct XcdBarrier { unsigned* bar; unsigned x; volatile LAS unsigned* st; };
__device__ __forceinline__ XcdBarrier xcd_barrier_post(unsigned* bar, volatile LAS unsigned* st) {
    XcdBarrier b; b.bar = bar; b.x = xb_xcc_id(); b.st = st;
    if (threadIdx.x == 0) (void)xb_add(&bar[XB_XCNT(b.x)], 1u);
    return b;
}
__device__ __forceinline__ void xcd_barrier_complete(unsigned* bar, unsigned x, unsigned& nloc, unsigned& nx) {
    const unsigned G = gridDim.x * gridDim.y * gridDim.z;
    unsigned sum, cnt, mine, sp = 0u;
    for (;;) {
        sum = 0u; cnt = 0u; mine = 0u;
#pragma unroll
        for (unsigned j = 0; j < 16; ++j) { const unsigned c = xb_ld(&bar[XB_XCNT(j)]); sum += c; cnt += (c > 0u) ? 1u : 0u; mine = (j == x) ? c : mine; }
        if (sum == G) break;
        __builtin_amdgcn_s_sleep(1);
        if ((++sp & 255u) == 0u) { if (xb_ld(&bar[XB_TMO])) break; if (sp > XB_SPIN_CAP) { atomicAdd(&bar[XB_TMO], 1u); break; } }
    }
    nloc = mine > 0u ? mine : 1u; nx = cnt > 0u ? cnt : 1u;
}
__device__ __forceinline__ void xcd_barrier(const XcdBarrier& b) {
    asm volatile("s_waitcnt vmcnt(0)" ::: "memory");
    __syncthreads();
    if (threadIdx.x == 0) {
        unsigned* bar = b.bar;
        __builtin_amdgcn_s_waitcnt(0);
        unsigned nloc = b.st[0], nx = b.st[1];
        if (nloc == 0u) { xcd_barrier_complete(bar, b.x, nloc, nx); b.st[0] = nloc; b.st[1] = nx; }
        const unsigned old = xb_add(&bar[XB_XSUB(b.x)], 1u);
        const unsigned gen = old / nloc;
        if (old + 1u == (gen + 1u) * nloc) {
            __builtin_amdgcn_fence(__ATOMIC_RELEASE, "agent");
            asm volatile("s_waitcnt vmcnt(0)" ::: "memory");
            const unsigned og = xb_add(&bar[XB_TOP], 1u);
            const unsigned tg = og / nx;
            if (og + 1u == (tg + 1u) * nx) xb_add(&bar[XB_TOPGEN], 1u);
            else XB_SPIN(xb_ld(&bar[XB_TOPGEN]) == tg, bar);
            __builtin_amdgcn_fence(__ATOMIC_ACQUIRE, "agent");
            xb_add(&bar[XB_XGEN(b.x)], 1u);
            asm volatile("s_waitcnt vmcnt(0)" ::: "memory");
        } else {
            XB_SPIN(xb_ld(&bar[XB_XGEN(b.x)]) == gen, bar);
            __builtin_amdgcn_fence(__ATOMIC_ACQUIRE, "agent");
            asm volatile("s_waitcnt vmcnt(0)" ::: "memory");
        }
    }
    __syncthreads();
}

struct Args { const float* in[21]; float* out; unsigned char* ws; int ph_lo, ph_hi; };
static_assert(sizeof(Args) == 24 * 8, "Args has no holes");
struct Frame {
    LAS unsigned char* lds;
    unsigned char* ldsg;
    volatile LAS unsigned* MISC;
    unsigned* ctl;
    int tid, lane, wave, G;
    unsigned char* ws;
};
enum { I_X = 0, I_META, I_N1G, I_F1W1, I_F1W3, I_F1W2, I_NMIXG, I_WIN, I_FBIAS, I_AW2, I_AB, I_GNG, I_WGATE, I_WPF, I_WPG, I_WOUT, I_N2G, I_F2W1, I_F2W3, I_F2W2, I_NFG };

struct CvtRegs { f32x4 v[8][2]; };
__device__ __forceinline__ void cvt_load(CvtRegs& R, const float* src, int ldsrc, int srccol0, int k0, int n0, int lane) {
    const int g = lane >> 4, c = lane & 15;
#pragma unroll
    for (int j = 0; j < 8; ++j)
#pragma unroll
        for (int e = 0; e < 2; ++e) R.v[j][e] = *(const f32x4*)(src + (size_t)(k0 + 8 * j + 2 * g + e) * ldsrc + srccol0 + n0 + 4 * c);
}
template <bool ILV>
__device__ __forceinline__ void cvt_store(const CvtRegs& R, int k0, int n0, bf16* dst, int lddst, int dstcol0, int dstrow0, LAS unsigned* T, int lane) {
    const int g = lane >> 4, c = lane & 15;
#pragma unroll
    for (int j = 0; j < 8; ++j)
#pragma unroll
        for (int i = 0; i < 4; ++i) T[(4 * c + i) * 33 + 4 * j + g] = pk2(R.v[j][0][i], R.v[j][1][i]);
    LDS_WAIT(); asm volatile("" ::: "memory");
    const int cc = lane & 7;
#pragma unroll
    for (int q = 0; q < 8; ++q) { const int n = 8 * q + (lane >> 3); const LAS unsigned* s = T + n * 33 + 4 * cc;
        v4u o; o.x = s[0]; o.y = s[1]; o.z = s[2]; o.w = s[3];
        const int nn = n0 + n, drow = dstrow0 + (ILV ? 256 * (nn >> 7) + (nn & 127) : nn);
        *(v4u*)(dst + (size_t)drow * lddst + dstcol0 + k0 + 8 * cc) = o; }
    LDS_WAIT(); asm volatile("" ::: "memory");
}
template <bool ILV>
__device__ __forceinline__ void cvt_matrix(Frame& F, const float* src, int ldsrc, int srccol0, int ncols, int K, bf16* dst, int lddst, int dstcol0, int dstrow0, int rot) {
    LAS unsigned* T = (LAS unsigned*)(F.lds + RING_OFF + F.wave * 8448);
    const int NGW = F.G * NWAVES; const int gw = ((int)blockIdx.x * NWAVES + F.wave + rot) % NGW;
    const int nnb = ncols / 64, ntiles = (K / 64) * nnb;
    CvtRegs Ra, Rb;
#define CVT_IT(j) ((((j) >> 1) * NGW + gw) * 2 + ((j) & 1))
    int j = 0;
    if (CVT_IT(0) < ntiles) cvt_load(Ra, src, ldsrc, srccol0, (CVT_IT(0) / nnb) * 64, (CVT_IT(0) % nnb) * 64, F.lane);
    for (;;) { const int i0 = CVT_IT(j), i1 = CVT_IT(j + 1), i2 = CVT_IT(j + 2);
        if (i0 >= ntiles) break;
        if (i1 < ntiles) cvt_load(Rb, src, ldsrc, srccol0, (i1 / nnb) * 64, (i1 % nnb) * 64, F.lane);
        cvt_store<ILV>(Ra, (i0 / nnb) * 64, (i0 % nnb) * 64, dst, lddst, dstcol0, dstrow0, T, F.lane);
        if (i1 >= ntiles) break;
        if (i2 < ntiles) cvt_load(Ra, src, ldsrc, srccol0, (i2 / nnb) * 64, (i2 % nnb) * 64, F.lane);
        cvt_store<ILV>(Rb, (i1 / nnb) * 64, (i1 % nnb) * 64, dst, lddst, dstcol0, dstrow0, T, F.lane);
        j += 2; }
#undef CVT_IT
}
constexpr int WSAMP = 4; constexpr float WCSIG = 3.9f, WSS_FIX = 1099511627776.0f  ;
__device__ __forceinline__ void wmax_fold(const CvtRegs& R, f32x4& mx, f32x4& sq) {
#pragma unroll
    for (int j = 0; j < 8; ++j)
#pragma unroll
        for (int e = 0; e < 2; ++e)
#pragma unroll
            for (int i = 0; i < 4; ++i) { mx[i] = fmaxf(mx[i], fabsf(R.v[j][e][i])); sq[i] += R.v[j][e][i] * R.v[j][e][i]; }
}
template <bool ILV>
__device__ __forceinline__ void wmax_matrix(Frame& F, const float* src, int ldsrc, int srccol0, int ncols, int K, int ch0, int rot) {
    unsigned* wmax = F.ctl + CW_WMAX + ch0; unsigned long long* wss = (unsigned long long*)(F.ctl + CW_WSS) + ch0;
    const int NGW = F.G * NWAVES; const int gw = ((int)blockIdx.x * NWAVES + F.wave + rot) % NGW;
    const int nnb = ncols / 64, nitems = nnb * (K / (128 * WSAMP));
    for (int it = gw; it < nitems; it += NGW) { const int n0 = (it % nnb) * 64, kb = (it / nnb) * (128 * WSAMP);
        CvtRegs Ra, Rb; f32x4 mx = {0.f, 0.f, 0.f, 0.f}, sq = {0.f, 0.f, 0.f, 0.f};
        cvt_load(Ra, src, ldsrc, srccol0, kb, n0, F.lane); cvt_load(Rb, src, ldsrc, srccol0, kb + 64, n0, F.lane);
        wmax_fold(Ra, mx, sq); wmax_fold(Rb, mx, sq);
#pragma unroll
        for (int i = 0; i < 4; ++i) { float m = mx[i], q = sq[i]; m = fmaxf(m, __shfl_xor(m, 16)); m = fmaxf(m, __shfl_xor(m, 32)); q += __shfl_xor(q, 16); q += __shfl_xor(q, 32);
            if (F.lane < 16) { const int nn = n0 + 4 * F.lane + i, ch = ILV ? 256 * (nn >> 7) + (nn & 127) : nn; atomicMax(wmax + ch, __float_as_uint(m)); atomicAdd(wss + ch, (unsigned long long)(q * WSS_FIX)); } } }
}
__device__ __forceinline__ void cvt8_load(CvtRegs& R, const float* src, int ldsrc, int srccol0, int k0, int n0, int lane) {
    const int g = lane >> 4, c = lane & 15;
#pragma unroll
    for (int j2 = 0; j2 < 4; ++j2)
#pragma unroll
        for (int e = 0; e < 4; ++e) R.v[2 * j2 + (e >> 1)][e & 1] = *(const f32x4*)(src + (size_t)(k0 + 16 * j2 + 4 * g + e) * ldsrc + srccol0 + n0 + 4 * c);
}
#define SAT127(x) __builtin_amdgcn_fmed3f((x), -127.0f, 127.0f)
__device__ __forceinline__ unsigned pack4_i8(float a, float b, float c, float d) {
    const int qa = (int)rintf(a), qb = (int)rintf(b), qc = (int)rintf(c), qd = (int)rintf(d);
    return (unsigned)(qa & 255) | ((unsigned)(qb & 255) << 8) | ((unsigned)(qc & 255) << 16) | ((unsigned)qd << 24);
}
template <bool ILV>
__device__ __forceinline__ void cvt8_store(const CvtRegs& R, int k0, int n0, unsigned char* dst, int lddst, int dstrow0, const unsigned* wmax, const unsigned long long* wss, float* wclip, float inv_ns, LAS unsigned* T, int lane) {
    const int g = lane >> 4, c = lane & 15;
    float sc[4];
#pragma unroll
    for (int i = 0; i < 4; ++i) { const int nn = n0 + 4 * c + i, ch = ILV ? 256 * (nn >> 7) + (nn & 127) : nn; const float m = fmaxf(__uint_as_float(wmax[ch]), WCSIG * sqrtf((float)wss[ch] * (inv_ns / WSS_FIX))); sc[i] = m > 0.f ? 127.0f / m : 0.f;
        if (k0 == 0 && g == 0) wclip[ch] = m; }
#pragma unroll
    for (int j2 = 0; j2 < 4; ++j2)
#pragma unroll
        for (int i = 0; i < 4; ++i) T[(4 * c + i) * 17 + 4 * j2 + g] = pack4_i8(SAT127(R.v[2 * j2][0][i] * sc[i]), SAT127(R.v[2 * j2][1][i] * sc[i]), SAT127(R.v[2 * j2 + 1][0][i] * sc[i]), SAT127(R.v[2 * j2 + 1][1][i] * sc[i]));
    LDS_WAIT(); asm volatile("" ::: "memory");
    const int cc = lane & 3;
#pragma unroll
    for (int q = 0; q < 4; ++q) { const int n = 16 * q + (lane >> 2); const LAS unsigned* t = T + n * 17 + 4 * cc;
        v4u o; o.x = t[0]; o.y = t[1]; o.z = t[2]; o.w = t[3];
        const int nn = n0 + n, drow = dstrow0 + (ILV ? 256 * (nn >> 7) + (nn & 127) : nn);
        *(v4u*)(dst + (size_t)drow * lddst + k0 + 16 * cc) = o; }
    LDS_WAIT(); asm volatile("" ::: "memory");
}
template <bool ILV>
__device__ __forceinline__ void cvt8_matrix(Frame& F, const float* src, int ldsrc, int srccol0, int ncols, int K, unsigned char* dst, int lddst, int dstrow0, int ch0, int rot, int wg, int nwg, int wv, int nwv, int tbase, int e_lo = 0, int e_hi = 8) {
    const unsigned* wmax = F.ctl + CW_WMAX + ch0; const unsigned long long* wss = (const unsigned long long*)(F.ctl + CW_WSS) + ch0; float* wclip = (float*)(F.ws + WS_WCLIP) + ch0; const float inv_ns = (float)WSAMP / (float)K;
    LAS unsigned* T = (LAS unsigned*)(F.lds + tbase + wv * 8448);
    const int NGW = nwg * nwv; const int gw = (wg * nwv + wv + rot) % NGW;
    const int nnb = ncols / 64, npairs = (K / 64) * nnb / 2, pair_lo = (int)((long)npairs * e_lo / 8), ntiles = 2 * (int)((long)npairs * e_hi / 8);
    CvtRegs Ra, Rb;
#define CVT_IT(j) ((pair_lo + ((j) >> 1) * NGW + gw) * 2 + ((j) & 1))
    int j = 0;
    if (CVT_IT(0) < ntiles) cvt8_load(Ra, src, ldsrc, srccol0, (CVT_IT(0) / nnb) * 64, (CVT_IT(0) % nnb) * 64, F.lane);
    for (;;) { const int i0 = CVT_IT(j), i1 = CVT_IT(j + 1), i2 = CVT_IT(j + 2);
        if (i0 >= ntiles) break;
        if (i1 < ntiles) cvt8_load(Rb, src, ldsrc, srccol0, (i1 / nnb) * 64, (i1 % nnb) * 64, F.lane);
        cvt8_store<ILV>(Ra, (i0 / nnb) * 64, (i0 % nnb) * 64, dst, lddst, dstrow0, wmax, wss, wclip, inv_ns, T, F.lane);
        if (i1 >= ntiles) break;
        if (i2 < ntiles) cvt8_load(Ra, src, ldsrc, srccol0, (i2 / nnb) * 64, (i2 % nnb) * 64, F.lane);
        cvt8_store<ILV>(Rb, (i1 / nnb) * 64, (i1 % nnb) * 64, dst, lddst, dstrow0, wmax, wss, wclip, inv_ns, T, F.lane);
        j += 2; }
#undef CVT_IT
}
__device__ __forceinline__ void n1_row(Frame& F, const Args& A, int pos, unsigned char* orow, float* rs) {
    GAS unsigned* o4 = (GAS unsigned*)orow + F.lane;
    if (pos >= L) {
#pragma unroll
        for (int j = 0; j < 16; ++j) o4[64 * j] = 0u;
        if (F.lane == 0) rs[pos] = 0.f;
        return; }
    const float* xrow = pos < NMETA ? A.in[I_META] + (size_t)pos * DM : A.in[I_X] + (size_t)(pos - NMETA) * DM;
    const f32x4* xr = (const f32x4*)xrow + F.lane; const f32x4* gr = (const f32x4*)A.in[I_N1G] + F.lane;
    f32x4 v[16]; float s = 0.f;
#pragma unroll
    for (int j = 0; j < 16; ++j) { v[j] = xr[64 * j]; s += (v[j].x * v[j].x + v[j].y * v[j].y) + (v[j].z * v[j].z + v[j].w * v[j].w); }
    const float rstd = 1.0f / sqrtf(wave_sum(s) * (1.f / DM) + EPS);
    float am = 0.f;
#pragma unroll
    for (int j = 0; j < 16; ++j) { v[j] = v[j] * rstd * gr[64 * j]; am = fmaxf(am, fmaxf(fmaxf(fabsf(v[j].x), fabsf(v[j].y)), fmaxf(fabsf(v[j].z), fabsf(v[j].w)))); }
#pragma unroll
    for (int o = 1; o < 64; o <<= 1) am = fmaxf(am, __shfl_xor(am, o));
    const float sc = am > 0.f ? 127.0f / am : 0.f;
#pragma unroll
    for (int j = 0; j < 16; ++j) o4[64 * j] = pack4_i8(v[j].x * sc, v[j].y * sc, v[j].z * sc, v[j].w * sc);
    if (F.lane == 0) rs[pos] = am * (1.0f / 127.0f);
}
__device__ __forceinline__ void quantise_ffn1(Frame& F, const Args& A) {
    cvt8_matrix<true >(F, A.in[I_F1W3], DFF, 0, DFF, DM, F.ws + WS_W1A, DM, 128, WCH_F1 + 128, 517, (int)blockIdx.x, F.G, F.wave, NWAVES, RING_OFF);
    cvt8_matrix<true >(F, A.in[I_F1W1], DFF, 0, DFF, DM, F.ws + WS_W1A, DM, 0, WCH_F1, 0, (int)blockIdx.x, F.G, F.wave, NWAVES, RING_OFF);
    __syncthreads();
}
__device__ __forceinline__ void quantise_late(Frame& F, const Args& A, int wg, int nwg, int wv, int nwv, int tbase, int e_lo, int e_hi) {
    unsigned char* WG8 = F.ws + WS_WG8;
    cvt8_matrix<true >(F, A.in[I_WGATE], 2 * DM, DM, DM, DM, WG8, DM, 128, WCH_G + 128, 1301, wg, nwg, wv, nwv, tbase, e_lo, e_hi);
    cvt8_matrix<true >(F, A.in[I_WGATE], 2 * DM, 0, DM, DM, WG8, DM, 0, WCH_G, 89, wg, nwg, wv, nwv, tbase, e_lo, e_hi);
    cvt8_matrix<true >(F, A.in[I_F2W3], DFF, 0, DFF, DM, F.ws + WS_W2A, DM, 128, WCH_F2 + 128, 1700, wg, nwg, wv, nwv, tbase, e_lo, e_hi);
    cvt8_matrix<true >(F, A.in[I_F2W1], DFF, 0, DFF, DM, F.ws + WS_W2A, DM, 0, WCH_F2, 1111, wg, nwg, wv, nwv, tbase, e_lo, e_hi);
}
__device__ __forceinline__ void p0_prologue(Frame& F, const Args& A) {
    unsigned char* ws = F.ws;
    bf16* W1A = (bf16*)(ws + WS_W1A); bf16* W1B = (bf16*)(ws + WS_W1B); bf16* WINb = (bf16*)(ws + WS_WIN); bf16* WP = (bf16*)(ws + WS_WP); bf16* WO = (bf16*)(ws + WS_WO);
    bf16* W2A = (bf16*)(ws + WS_W2A); bf16* W2B = (bf16*)(ws + WS_W2B);
    cvt_matrix<false>(F, A.in[I_F1W2], DM, 0, DM, DFF, W1B, DFF, 0, 0, 1031);
    cvt_matrix<false>(F, A.in[I_WIN], DIN, 0, 6144, DM, WINb, DM, 0, 0, 211);
    cvt_matrix<false>(F, A.in[I_WIN], DIN, 6160, 6144, DM, WINb, DM, 0, 6144, 1543);
    cvt_matrix<false>(F, A.in[I_WPF], DM, 0, DM, FOXW, WP, DM, 0, 0, 700);
    cvt_matrix<false>(F, A.in[I_WPG], DM, 0, DM, GVW, WP, DM, FOXW, 0, 1900);
    cvt_matrix<false>(F, A.in[I_WOUT], DM, 0, DM, DM, WO, DM, 0, 0, 333);
    cvt_matrix<false>(F, A.in[I_F2W2], DM, 0, DM, DFF, W2B, DFF, 0, 0, 59);
    { const size_t gt = (size_t)blockIdx.x * 512 + F.tid, NT = (size_t)F.G * 512;
      for (size_t i = gt; i < (size_t)256 * DM; i += NT) { const int r = (int)(i / DM), k = (int)(i % DM); float v = 0.f;
          if (r < 16) v = A.in[I_WIN][(size_t)k * DIN + 6144 + r]; else if (r < 32) v = A.in[I_WIN][(size_t)k * DIN + 12304 + (r - 16)];
          WINb[(size_t)(WIN_SMALL + r) * DM + k] = (bf16)(pk2(v, 0.f) & 0xffffu); } }
    wmax_matrix<true >(F, A.in[I_F2W1], DFF, 0, DFF, DM, WCH_F2, 1111);
    wmax_matrix<true >(F, A.in[I_F1W1], DFF, 0, DFF, DM, WCH_F1, 0);
    wmax_matrix<true >(F, A.in[I_F1W3], DFF, 0, DFF, DM, WCH_F1 + 128, 517);
    wmax_matrix<true >(F, A.in[I_F2W3], DFF, 0, DFF, DM, WCH_F2 + 128, 1700);
    wmax_matrix<true >(F, A.in[I_WGATE], 2 * DM, 0, DM, DM, WCH_G, 89);
    wmax_matrix<true >(F, A.in[I_WGATE], 2 * DM, DM, DM, DM, WCH_G + 128, 1301);
    { unsigned char* A8_ = ws + WS_A8; const int gw = (int)blockIdx.x * NWAVES + F.wave, NGW = F.G * NWAVES;
      for (int m = gw; m < LP; m += NGW) n1_row(F, A, m, A8_ + (size_t)m * DM, (float*)(ws + WS_RS1)); }
}

typedef pg8::f32x4 A4;
__device__ __forceinline__ void ss_add(ssq_t* p, float sq) { atomicAdd(p, (unsigned long long)(sq * SSFIX)); }
__device__ __forceinline__ float rstd_of(const ssq_t* ss, int row) { return __builtin_amdgcn_rsqf((float)ss[row] * (1.f / (DM * SSFIX)) + EPS); }

__device__ __forceinline__ void rstd8(const ssq_t* ss, int row0, float (&s)[8]) {
    ssq_t t[8];
#pragma unroll
    for (int i = 0; i < 8; ++i) t[i] = ss[row0 + (i >> 2) * 128 + (i & 3) * 16];
#pragma unroll
    for (int i = 0; i < 8; ++i) s[i] = __builtin_amdgcn_rsqf((float)t[i] * (1.f / (DM * SSFIX)) + EPS);
}

struct EpiSwiGLU {
    bf16* O; const ssq_t* ss;
    __device__ __forceinline__ void operator()(const A4 (&acc)[2][2][4][2], const pg8::Unit& u, int wr, int wc, int fr, int fq) const {
        const int row0 = u.arow + wr * 64 + fr, col0 = u.pn * 128 + wc * 32 + 8 * fq;
        float sv[8] = {1.f, 1.f, 1.f, 1.f, 1.f, 1.f, 1.f, 1.f}; if (ss) rstd8(ss, row0, sv);
#pragma unroll
        for (int ai = 0; ai < 2; ++ai)
#pragma unroll
            for (int m = 0; m < 4; ++m) { const int row = row0 + ai * 128 + m * 16; const float s = sv[ai * 4 + m];
                const A4 a0 = acc[ai][0][m][0] * s, a1 = acc[ai][0][m][1] * s, b0 = acc[ai][1][m][0] * s, b1 = acc[ai][1][m][1] * s;
                v4u w; w.x = pk2(siluf_fast(a0[0]) * b0[0], siluf_fast(a0[1]) * b0[1]); w.y = pk2(siluf_fast(a0[2]) * b0[2], siluf_fast(a0[3]) * b0[3]);
                w.z = pk2(siluf_fast(a1[0]) * b1[0], siluf_fast(a1[1]) * b1[1]); w.w = pk2(siluf_fast(a1[2]) * b1[2], siluf_fast(a1[3]) * b1[3]);
                *(v4u*)(O + (size_t)row * DFF + col0) = w; }
    }
};
template <int MODE> struct EpiResid {
    const float* x; const float* meta; const bf16* H; float* dout; bf16* anext; const float* gnext; ssq_t* ss; float alpha; bf16* Hout;
    __device__ __forceinline__ void operator()(const A4 (&acc)[2][2][4][2], const pg8::Unit& u, int wr, int wc, int fr, int fq) const {
        const int row0 = u.arow + wr * 64 + fr, col0 = u.pn * 256 + wc * 32 + 8 * fq;
        A4 gv[2][2];
        if (MODE != 2) {
#pragma unroll
            for (int bj = 0; bj < 2; ++bj)
#pragma unroll
                for (int n = 0; n < 2; ++n) gv[bj][n] = *(const A4*)(gnext + col0 + bj * 128 + 4 * n); }
        A4 hv[2][4];
#define RES_LOAD(slot, gi) do { const int row_ = row0 + ((gi) >> 2) * 128 + ((gi) & 3) * 16; \
            if (MODE == 0) { const float* hp_; bool z_ = false; if (row_ < NMETA) hp_ = meta + (size_t)row_ * DM; else if (row_ < L) hp_ = x + (size_t)(row_ - NMETA) * DM; else { hp_ = x; z_ = true; } \
                _Pragma("unroll") for (int q_ = 0; q_ < 4; ++q_) { hv[slot][q_] = *(const A4*)(hp_ + col0 + (q_ >> 1) * 128 + 4 * (q_ & 1)); if (z_) hv[slot][q_] = (A4){0.f, 0.f, 0.f, 0.f}; } } \
            else { _Pragma("unroll") for (int b_ = 0; b_ < 2; ++b_) { const v4u w_ = *(const v4u*)(H + (size_t)row_ * DM + col0 + b_ * 128); \
                hv[slot][2 * b_] = (A4){bf_lo(w_.x), bf_hi(w_.x), bf_lo(w_.y), bf_hi(w_.y)}; hv[slot][2 * b_ + 1] = (A4){bf_lo(w_.z), bf_hi(w_.z), bf_lo(w_.w), bf_hi(w_.w)}; } } } while (0)
        RES_LOAD(0, 0);
#pragma unroll
        for (int gi = 0; gi < 8; ++gi) { const int ai = gi >> 2, m = gi & 3, row = row0 + ai * 128 + m * 16, sl = gi & 1;
            if (gi + 1 < 8) RES_LOAD((gi + 1) & 1, gi + 1);
            float sq = 0.f;
#pragma unroll
            for (int bj = 0; bj < 2; ++bj) { A4 v[2];
#pragma unroll
                for (int n = 0; n < 2; ++n) { v[n] = hv[sl][bj * 2 + n] + acc[ai][bj][m][n] * alpha; sq += (v[n][0] * v[n][0] + v[n][1] * v[n][1]) + (v[n][2] * v[n][2] + v[n][3] * v[n][3]);
                    }
                { v4u hw; hw.x = pk2(v[0][0], v[0][1]); hw.y = pk2(v[0][2], v[0][3]); hw.z = pk2(v[1][0], v[1][1]); hw.w = pk2(v[1][2], v[1][3]);
                    *(v4u*)(Hout + (size_t)row * DM + col0 + bj * 128) = hw; }
                if (MODE != 2) { const A4 p = v[0] * gv[bj][0], q = v[1] * gv[bj][1]; v4u w; w.x = pk2(p[0], p[1]); w.y = pk2(p[2], p[3]); w.z = pk2(q[0], q[1]); w.w = pk2(q[2], q[3]);
                    *(v4u*)(anext + (size_t)row * DM + col0 + bj * 128) = w; } }
            sq += __shfl_xor(sq, 16); sq += __shfl_xor(sq, 32);
            if (fq == 0) ss_add(ss + row, sq); }
#undef RES_LOAD
    }
};
struct PanelOrder { int G, c;
    __device__ bool next(int i, pg8::Unit& u) const { const int Lu = i * G + c; if (Lu >= 512) return false; int pm, pn;
        if (G == 256) { const int x = c & 7, k = c >> 3; pm = 16 * i + 8 * (x >> 2) + (k & 7); pn = 4 * (x & 3) + (k >> 3); }
        else { pm = Lu >> 4; pn = Lu & 15; }
        u.arow = NMETA + pm * 256; u.brow = pn * 256; u.pn = pn; return true; } };
struct EpiFinal {
    const bf16* H; float* out; const float* gfin; ssq_t* ss; unsigned* cnt; unsigned* bar; float alpha;
    __device__ __forceinline__ void operator()(A4 (&acc)[2][2][4][2], const pg8::Unit& u, int wr, int wc, int fr, int fq) const {
        const int row0 = u.arow + wr * 64 + fr, col0 = u.pn * 256 + wc * 32 + 8 * fq;
        A4 hv[2][4];
#define FIN_LOAD(slot, gi) do { const int row_ = row0 + ((gi) >> 2) * 128 + ((gi) & 3) * 16; \
            _Pragma("unroll") for (int b_ = 0; b_ < 2; ++b_) { const v4u w_ = *(const v4u*)(H + (size_t)row_ * DM + col0 + b_ * 128); \
                hv[slot][2 * b_] = (A4){bf_lo(w_.x), bf_hi(w_.x), bf_lo(w_.y), bf_hi(w_.y)}; hv[slot][2 * b_ + 1] = (A4){bf_lo(w_.z), bf_hi(w_.z), bf_lo(w_.w), bf_hi(w_.w)}; } } while (0)
        FIN_LOAD(0, 0);
#pragma unroll
        for (int gi = 0; gi < 8; ++gi) { const int ai = gi >> 2, m = gi & 3, row = row0 + ai * 128 + m * 16, sl = gi & 1;
            if (gi + 1 < 8) FIN_LOAD((gi + 1) & 1, gi + 1);
            float sq = 0.f;
#pragma unroll
            for (int bj = 0; bj < 2; ++bj)
#pragma unroll
                for (int n = 0; n < 2; ++n) { const A4 v = hv[sl][bj * 2 + n] + acc[ai][bj][m][n] * alpha; acc[ai][bj][m][n] = v; sq += (v[0] * v[0] + v[1] * v[1]) + (v[2] * v[2] + v[3] * v[3]); }
            sq += __shfl_xor(sq, 16); sq += __shfl_xor(sq, 32);
            if (fq == 0) ss_add(ss + row, sq); }
#undef FIN_LOAD
        asm volatile("s_waitcnt vmcnt(0)" ::: "memory");
        __syncthreads();
        if (threadIdx.x == 0) { unsigned* p = cnt + ((u.arow - NMETA) >> 8) * 16;
            __builtin_amdgcn_fence(__ATOMIC_RELEASE, "agent"); (void)xb_add(p, 1u);
            XB_SPIN(xb_ld(p) < 16u, bar);
            __builtin_amdgcn_fence(__ATOMIC_ACQUIRE, "agent"); }
        __syncthreads();
        float sv[8];
        { float t[8];
#pragma unroll
          for (int i = 0; i < 8; ++i) t[i] = (float)__hip_atomic_load(ss + row0 + (i >> 2) * 128 + (i & 3) * 16, RLX_AGENT) * (1.0f / SSFIX);
#pragma unroll
          for (int i = 0; i < 8; ++i) sv[i] = 1.0f / sqrtf(t[i] * (1.f / DM) + EPS); }
        A4 gv[2][2];
#pragma unroll
        for (int bj = 0; bj < 2; ++bj)
#pragma unroll
            for (int n = 0; n < 2; ++n) gv[bj][n] = *(const A4*)(gfin + col0 + bj * 128 + 4 * n);
#pragma unroll
        for (int gi = 0; gi < 8; ++gi) { const int ai = gi >> 2, m = gi & 3, row = row0 + ai * 128 + m * 16; const float s = sv[gi];
            float* op = out + (size_t)(row - NMETA) * DM + col0;
#pragma unroll
            for (int bj = 0; bj < 2; ++bj)
#pragma unroll
                for (int n = 0; n < 2; ++n) *(A4*)(op + bj * 128 + 4 * n) = acc[ai][bj][m][n] * s * gv[bj][n]; }
    }
};
struct EpiResidQ {
    bf16* H; const float* gnext; ssq_t* ss; unsigned* amax; unsigned char* A8; float* rs; unsigned* cnt; unsigned* bar;
    __device__ __forceinline__ void operator()(A4 (&acc)[2][2][4][2], const pg8::Unit& u, int wr, int wc, int fr, int fq) const {
        const int row0 = u.arow + wr * 64 + fr, col0 = u.pn * 256 + wc * 32 + 8 * fq;
        A4 gv[2][2];
#pragma unroll
        for (int bj = 0; bj < 2; ++bj)
#pragma unroll
            for (int n = 0; n < 2; ++n) gv[bj][n] = *(const A4*)(gnext + col0 + bj * 128 + 4 * n);
        A4 hv[2][4];
#define FIN_LOAD(slot, gi) do { const int row_ = row0 + ((gi) >> 2) * 128 + ((gi) & 3) * 16; \
            _Pragma("unroll") for (int b_ = 0; b_ < 2; ++b_) { const v4u w_ = *(const v4u*)(H + (size_t)row_ * DM + col0 + b_ * 128); \
                hv[slot][2 * b_] = (A4){bf_lo(w_.x), bf_hi(w_.x), bf_lo(w_.y), bf_hi(w_.y)}; hv[slot][2 * b_ + 1] = (A4){bf_lo(w_.z), bf_hi(w_.z), bf_lo(w_.w), bf_hi(w_.w)}; } } while (0)
        FIN_LOAD(0, 0);
#pragma unroll
        for (int gi = 0; gi < 8; ++gi) { const int ai = gi >> 2, m = gi & 3, row = row0 + ai * 128 + m * 16, sl = gi & 1;
            if (gi + 1 < 8) FIN_LOAD((gi + 1) & 1, gi + 1);
            float sq = 0.f, am = 0.f;
#pragma unroll
            for (int bj = 0; bj < 2; ++bj) { A4 v[2];
#pragma unroll
                for (int n = 0; n < 2; ++n) { v[n] = hv[sl][bj * 2 + n] + acc[ai][bj][m][n]; sq += (v[n][0] * v[n][0] + v[n][1] * v[n][1]) + (v[n][2] * v[n][2] + v[n][3] * v[n][3]);
                    const A4 p = v[n] * gv[bj][n]; acc[ai][bj][m][n] = p; am = fmaxf(am, fmaxf(fmaxf(fabsf(p[0]), fabsf(p[1])), fmaxf(fabsf(p[2]), fabsf(p[3])))); }
                v4u hw; hw.x = pk2(v[0][0], v[0][1]); hw.y = pk2(v[0][2], v[0][3]); hw.z = pk2(v[1][0], v[1][1]); hw.w = pk2(v[1][2], v[1][3]);
                *(v4u*)(H + (size_t)row * DM + col0 + bj * 128) = hw; }
            sq += __shfl_xor(sq, 16); sq += __shfl_xor(sq, 32); am = fmaxf(am, __shfl_xor(am, 16)); am = fmaxf(am, __shfl_xor(am, 32));
            if (fq == 0) { ss_add(ss + row, sq); atomicMax(amax + row, __float_as_uint(am)); } }
#undef FIN_LOAD
        asm volatile("s_waitcnt vmcnt(0)" ::: "memory");
        __syncthreads();
        if (threadIdx.x == 0) { unsigned* p = cnt + ((u.arow - NMETA) >> 8) * 16;
            __builtin_amdgcn_fence(__ATOMIC_RELEASE, "agent"); (void)xb_add(p, 1u);
            XB_SPIN(xb_ld(p) < 16u, bar);
            __builtin_amdgcn_fence(__ATOMIC_ACQUIRE, "agent"); }
        __syncthreads();
        float av[8];
#pragma unroll
        for (int i = 0; i < 8; ++i) av[i] = __uint_as_float(__hip_atomic_load(amax + row0 + (i >> 2) * 128 + (i & 3) * 16, RLX_AGENT));
        if (u.pn == 0 && wc == 0 && fq == 0) {
#pragma unroll
            for (int i = 0; i < 8; ++i) { const int row = row0 + (i >> 2) * 128 + (i & 3) * 16; rs[row] = av[i] * (1.0f / 127.0f) / sqrtf((float)__hip_atomic_load(ss + row, RLX_AGENT) * (1.f / (DM * SSFIX)) + EPS); } }
#pragma unroll
        for (int gi = 0; gi < 8; ++gi) { const int ai = gi >> 2, m = gi & 3, row = row0 + ai * 128 + m * 16; const float sc = av[gi] > 0.f ? 127.0f / av[gi] : 0.f;
#pragma unroll
            for (int bj = 0; bj < 2; ++bj) { const A4 p = acc[ai][bj][m][0] * sc, q = acc[ai][bj][m][1] * sc; v2u o; o.x = pack4_i8(p[0], p[1], p[2], p[3]); o.y = pack4_i8(q[0], q[1], q[2], q[3]);
                *(v2u*)(A8 + (size_t)row * DM + col0 + bj * 128) = o; } }
    }
};
struct EpiSwiGLUQ {
    bf16* O; const float* rs; const float* wmax;
    __device__ __forceinline__ void operator()(const A4 (&acc)[2][2][4][2], const pg8::Unit& u, int wr, int wc, int fr, int fq) const {
        const int row0 = u.arow + wr * 64 + fr, col0 = u.pn * 128 + wc * 32 + 8 * fq;
        float sv[8];
#pragma unroll
        for (int i = 0; i < 8; ++i) sv[i] = rs[row0 + (i >> 2) * 128 + (i & 3) * 16];
        A4 wv[2][2];
#pragma unroll
        for (int bj = 0; bj < 2; ++bj)
#pragma unroll
            for (int n = 0; n < 2; ++n) wv[bj][n] = *(const A4*)(wmax + u.pn * 256 + bj * 128 + wc * 32 + 8 * fq + 4 * n) * (1.0f / 127.0f);
#pragma unroll
        for (int ai = 0; ai < 2; ++ai)
#pragma unroll
            for (int m = 0; m < 4; ++m) { const int row = row0 + ai * 128 + m * 16; const float s = sv[ai * 4 + m];
                const A4 a0 = acc[ai][0][m][0] * s * wv[0][0], a1 = acc[ai][0][m][1] * s * wv[0][1], b0 = acc[ai][1][m][0] * s * wv[1][0], b1 = acc[ai][1][m][1] * s * wv[1][1];
                v4u w; w.x = pk2(siluf_fast(a0[0]) * b0[0], siluf_fast(a0[1]) * b0[1]); w.y = pk2(siluf_fast(a0[2]) * b0[2], siluf_fast(a0[3]) * b0[3]);
                w.z = pk2(siluf_fast(a1[0]) * b1[0], siluf_fast(a1[1]) * b1[1]); w.w = pk2(siluf_fast(a1[2]) * b1[2], siluf_fast(a1[3]) * b1[3]);
                *(v4u*)(O + (size_t)row * DFF + col0) = w; }
    }
};
struct EpiWin {
    const ssq_t* ss; unsigned char* ws;
    __device__ __forceinline__ void operator()(const A4 (&acc)[2][2][4][2], const pg8::Unit& u, int wr, int wc, int fr, int fq) const {
        const int row0 = u.arow + wr * 64 + fr, pn = u.pn;
        if (pn == 48) {
            if (wc == 0) { float* SM = (float*)(ws + WS_SM) + 8 * fq;
#pragma unroll
                for (int ai = 0; ai < 2; ++ai)
#pragma unroll
                    for (int m = 0; m < 4; ++m) { const int row = row0 + ai * 128 + m * 16; const float s = rstd_of(ss, row);
                        *(A4*)(SM + (size_t)row * 32) = acc[ai][0][m][0] * s; *(A4*)(SM + (size_t)row * 32 + 4) = acc[ai][0][m][1] * s; } }
            return; }
        size_t boff; int ldrow, bjs; float mul = 1.f; bool act = false;
        if (pn < 24) { boff = WS_FQ + (size_t)(pn >> 3) * (WS_FK - WS_FQ) + (size_t)(2 * (pn & 7)) * LP * FOXD * 2; ldrow = FOXD; bjs = LP * FOXD; }
        else if (pn < 28) { boff = WS_GQ + (size_t)(pn - 24) * 512; ldrow = GKW; bjs = 128; mul = 0.0625f; }
        else if (pn < 32) { boff = WS_GK + (size_t)(pn - 28) * 512; ldrow = GKW; bjs = 128; }
        else if (pn < 40) { boff = WS_GV + (size_t)(pn - 32) * 512; ldrow = GVW; bjs = 128; }
        else { boff = WS_GR + (size_t)(pn - 40) * 512; ldrow = GVW; bjs = 128; act = true; }
        char* basec = (char*)ws + boff + (wc * 32 + 8 * fq) * 2;
        float sv[8]; rstd8(ss, row0, sv);
#pragma unroll
        for (int ai = 0; ai < 2; ++ai)
#pragma unroll
            for (int m = 0; m < 4; ++m) { const int row = row0 + ai * 128 + m * 16; const float s = sv[ai * 4 + m] * mul;
#pragma unroll
                for (int bj = 0; bj < 2; ++bj) { A4 a0 = acc[ai][bj][m][0] * s, a1 = acc[ai][bj][m][1] * s;
                    if (act) {
#pragma unroll
                        for (int j = 0; j < 4; ++j) { a0[j] = siluf_fast(a0[j]); a1[j] = siluf_fast(a1[j]); } }
                    v4u w; w.x = pk2(a0[0], a0[1]); w.y = pk2(a0[2], a0[3]); w.z = pk2(a1[0], a1[1]); w.w = pk2(a1[2], a1[3]);
                    *(v4u*)(basec + (size_t)(unsigned)((row * ldrow + bj * bjs) * 2)) = w; }
                asm volatile("" ::: "memory"); }
    }
};
struct EpiGate {
    const float* rs; const float* wmax; bf16* GA; bf16* GB; int nai;
    __device__ __forceinline__ void operator()(const A4 (&acc)[2][2][4][2], const pg8::Unit& u, int wr, int wc, int fr, int fq) const {
        const int row0 = u.arow + wr * 64 + fr, col0 = u.pn * 128 + wc * 32 + 8 * fq;
        float sv[8];
#pragma unroll
        for (int i = 0; i < 8; ++i) sv[i] = rs[row0 + (i >> 2) * 128 + (i & 3) * 16];
        A4 wv[2][2];
#pragma unroll
        for (int bj = 0; bj < 2; ++bj)
#pragma unroll
            for (int n = 0; n < 2; ++n) wv[bj][n] = *(const A4*)(wmax + u.pn * 256 + bj * 128 + wc * 32 + 8 * fq + 4 * n) * (1.0f / 127.0f);
#pragma unroll
        for (int ai = 0; ai < 2; ++ai)
#pragma unroll
            for (int m = 0; m < 4; ++m) { if (ai >= nai) continue; const int row = row0 + ai * 128 + m * 16; const float s = sv[ai * 4 + m];
#pragma unroll
                for (int bj = 0; bj < 2; ++bj) { const A4 a0 = acc[ai][bj][m][0] * s * wv[bj][0], a1 = acc[ai][bj][m][1] * s * wv[bj][1];
                    v4u w; w.x = pk2(sigmoidf_fast(a0[0]), sigmoidf_fast(a0[1])); w.y = pk2(sigmoidf_fast(a0[2]), sigmoidf_fast(a0[3]));
                    w.z = pk2(sigmoidf_fast(a1[0]), sigmoidf_fast(a1[1])); w.w = pk2(sigmoidf_fast(a1[2]), sigmoidf_fast(a1[3]));
                    *(v4u*)((bj == 0 ? GA : GB) + (size_t)row * DM + col0) = w; } }
    }
};
struct HalfOrder { int c;
    __device__ bool next(int i, pg8::Unit& u) const { if (i > 0) return false; u.arow = 28 * 256 + 128 * (c >> 5); u.brow = 256 * (c & 31); u.pn = c & 31; return true; } };
template <int PASS> struct EpiProj {
    const bf16* Gt; bf16* Y; bf16* YBF;
    __device__ __forceinline__ void operator()(const A4 (&acc)[2][2][4][2], const pg8::Unit& u, int wr, int wc, int fr, int fq) const {
        const int row0 = u.arow + wr * 64 + fr, col0 = u.pn * 256 + wc * 32 + 8 * fq;
#pragma unroll
        for (int ai = 0; ai < 2; ++ai)
#pragma unroll
            for (int m = 0; m < 4; ++m) { const int row = row0 + ai * 128 + m * 16;
#pragma unroll
                for (int bj = 0; bj < 2; ++bj) { const size_t off = (size_t)row * DM + col0 + bj * 128;
                    const v4u gw = *(const v4u*)(Gt + off);
                    const A4 g0 = {bf_lo(gw.x), bf_hi(gw.x), bf_lo(gw.y), bf_hi(gw.y)}, g1 = {bf_lo(gw.z), bf_hi(gw.z), bf_lo(gw.w), bf_hi(gw.w)};
                    A4 y0 = g0 * acc[ai][bj][m][0], y1 = g1 * acc[ai][bj][m][1];
                    if (PASS == 1) { const v4u yw = *(const v4u*)(Y + off); y0 += (A4){bf_lo(yw.x), bf_hi(yw.x), bf_lo(yw.y), bf_hi(yw.y)}; y1 += (A4){bf_lo(yw.z), bf_hi(yw.z), bf_lo(yw.w), bf_hi(yw.w)}; }
                    v4u w; w.x = pk2(y0[0], y0[1]); w.y = pk2(y0[2], y0[3]); w.z = pk2(y1[0], y1[1]); w.w = pk2(y1[2], y1[3]);
                    *(v4u*)((PASS == 0 ? Y : YBF) + off) = w; }
                if (m & 1) asm volatile("" ::: "memory"); }
    }
};
constexpr int TAIL0 = 8192;
template <int NT>
__device__ __forceinline__ void skinny_tile(Frame& F, const bf16* S, int lds_, const bf16* T0, const bf16* T1, int ldt, int K, float& d0, float& d1) {
    typedef float f4 __attribute__((ext_vector_type(4)));
    LAS float* red = (LAS float*)(F.lds + RING_OFF);
    const int lane = F.lane, r = lane & 15, kq = lane >> 4, kslice = K / NWAVES, k0 = F.wave * kslice + 8 * kq;
    const bf16* sp = S + (size_t)r * lds_ + k0; const bf16* t0p = T0 + (size_t)r * ldt + k0; const bf16* t1p = T1 + (size_t)r * ldt + k0;
    f4 a0 = {0.f, 0.f, 0.f, 0.f}, a1 = {0.f, 0.f, 0.f, 0.f};
#pragma unroll 8
    for (int ks = 0; ks < kslice / 32; ++ks) { const bf16x8 sv = *(const bf16x8*)(sp + 32 * ks); const bf16x8 tv0 = *(const bf16x8*)(t0p + 32 * ks);
        a0 = __builtin_amdgcn_mfma_f32_16x16x32_bf16(tv0, sv, a0, 0, 0, 0);
        if (NT == 2) { const bf16x8 tv1 = *(const bf16x8*)(t1p + 32 * ks); a1 = __builtin_amdgcn_mfma_f32_16x16x32_bf16(tv1, sv, a1, 0, 0, 0); } }
    __syncthreads();
    *(LAS f4*)(red + (F.wave * NT + 0) * 256 + lane * 4) = a0;
    if (NT == 2) *(LAS f4*)(red + (F.wave * NT + 1) * 256 + lane * 4) = a1;
    __syncthreads();
    d0 = 0.f; d1 = 0.f;
    if (F.tid < 256) {
#pragma unroll
        for (int w = 0; w < NWAVES; ++w) { d0 += red[(w * NT + 0) * 256 + F.tid]; if (NT == 2) d1 += red[(w * NT + 1) * 256 + F.tid]; } }
}
template <int NT>
__device__ __forceinline__ void skinny_tile8(Frame& F, const unsigned char* S, const unsigned char* T0, const unsigned char* T1, int K, float& d0, float& d1) {
    LAS int* red = (LAS int*)(F.lds + RING_OFF);
    const int lane = F.lane, r = lane & 15, kq = lane >> 4, kslice = K / NWAVES, k0 = F.wave * kslice + 16 * kq;
    const unsigned char* sp = S + (size_t)r * K + k0; const unsigned char* t0p = T0 + (size_t)r * K + k0; const unsigned char* t1p = T1 + (size_t)r * K + k0;
    pg8::i32x4 a0 = {0, 0, 0, 0}, a1 = {0, 0, 0, 0};
#pragma unroll 8
    for (int ks = 0; ks < kslice / 64; ++ks) { const pg8::i32x4 sv = *(const pg8::i32x4*)(sp + 64 * ks); const pg8::i32x4 tv0 = *(const pg8::i32x4*)(t0p + 64 * ks);
        a0 = __builtin_amdgcn_mfma_i32_16x16x64_i8(tv0, sv, a0, 0, 0, 0);
        if (NT == 2) { const pg8::i32x4 tv1 = *(const pg8::i32x4*)(t1p + 64 * ks); a1 = __builtin_amdgcn_mfma_i32_16x16x64_i8(tv1, sv, a1, 0, 0, 0); } }
    __syncthreads();
    *(LAS pg8::i32x4*)(red + (F.wave * NT + 0) * 256 + lane * 4) = a0;
    if (NT == 2) *(LAS pg8::i32x4*)(red + (F.wave * NT + 1) * 256 + lane * 4) = a1;
    __syncthreads();
    int e0 = 0, e1 = 0;
    if (F.tid < 256) {
#pragma unroll
        for (int w = 0; w < NWAVES; ++w) { e0 += red[(w * NT + 0) * 256 + F.tid]; if (NT == 2) e1 += red[(w * NT + 1) * 256 + F.tid]; } }
    d0 = (float)e0; d1 = (float)e1;
}
__device__ __forceinline__ void skinny_p1(Frame& F, const unsigned char* n18, const float* rs, const unsigned char* W1A8, const float* wmax, bf16* HIDo) {
    for (int hb = (int)blockIdx.x; hb < DFF / 16; hb += F.G) { const int r1 = 256 * (hb >> 3) + 16 * (hb & 7); float a, b;
        skinny_tile8<2>(F, n18 + (size_t)TAIL0 * DM, W1A8 + (size_t)r1 * DM, W1A8 + (size_t)(r1 + 128) * DM, DM, a, b);
        if (F.tid < 256) { const int i = 4 * (F.tid >> 6) + (F.tid & 3), j = (F.tid >> 2) & 15; const float s = rs[TAIL0 + j] * (1.0f / 127.0f); a *= s * wmax[r1 + i]; b *= s * wmax[r1 + 128 + i];
            HIDo[(size_t)(TAIL0 + j) * DFF + 16 * hb + i] = (bf16)(pk2(siluf_fast(a) * b, 0.f) & 0xffffu); } }
    __syncthreads();
}
__device__ __forceinline__ void skinny_p2(Frame& F, const Args& A, const bf16* HIDi, const bf16* W1Bi, bf16* Ho, bf16* ABo, ssq_t* SS) {
    for (int cbk = (int)blockIdx.x; cbk < DM / 16; cbk += F.G) { float v, dummy;
        skinny_tile<1>(F, HIDi + (size_t)TAIL0 * DFF, DFF, W1Bi + (size_t)(16 * cbk) * DFF, W1Bi, DFF, DFF, v, dummy);
        if (F.tid < 256) { const int i = 4 * (F.tid >> 6) + (F.tid & 3), j = (F.tid >> 2) & 15, pos = TAIL0 + j, col = 16 * cbk + i;
            const float h1 = A.in[I_X][(size_t)(pos - NMETA) * DM + col] + 0.5f * v;
            Ho[(size_t)pos * DM + col] = (bf16)(pk2(h1, 0.f) & 0xffffu); ABo[(size_t)pos * DM + col] = (bf16)(pk2(h1 * A.in[I_NMIXG][col], 0.f) & 0xffffu);
            float sq = h1 * h1; sq += __shfl_xor(sq, 1); sq += __shfl_xor(sq, 2);
            if ((F.tid & 3) == 0) ss_add(SS + pos, sq); } }
    __syncthreads();
}
__device__ __forceinline__ void skinny_p3(Frame& F, const bf16* a2, const bf16* WINi, const ssq_t* SS) {
    unsigned char* ws = F.ws;
    constexpr int NB_TAIL = 770, NB_SMALL = TAIL0 / 16;
    for (int b = (int)blockIdx.x; b < NB_TAIL + NB_SMALL; b += F.G) {
        if (b < NB_TAIL) { const int row0 = 16 * b; float v, dummy;
            skinny_tile<1>(F, a2 + (size_t)TAIL0 * DM, DM, WINi + (size_t)row0 * DM, WINi, DM, DM, v, dummy);
            if (F.tid < 256) { const int i = 4 * (F.tid >> 6) + (F.tid & 3), j = (F.tid >> 2) & 15, pos = TAIL0 + j; const float s = rstd_of(SS, pos); v *= s;
                if (row0 < 6144) { const int T = row0 >> 11, head = (row0 & 2047) >> 7, d = (row0 & 127) + i;
                    ((bf16*)(ws + WS_FQ + (size_t)T * (WS_FK - WS_FQ)))[((size_t)head * LP + pos) * FOXD + d] = (bf16)(pk2(v, 0.f) & 0xffffu); }
                else if (row0 < 7168) ((bf16*)(ws + WS_GQ))[(size_t)pos * GKW + (row0 - 6144) + i] = (bf16)(pk2(v * 0.0625f, 0.f) & 0xffffu);
                else if (row0 < 8192) ((bf16*)(ws + WS_GK))[(size_t)pos * GKW + (row0 - 7168) + i] = (bf16)(pk2(v, 0.f) & 0xffffu);
                else if (row0 < 10240) ((bf16*)(ws + WS_GV))[(size_t)pos * GVW + (row0 - 8192) + i] = (bf16)(pk2(v, 0.f) & 0xffffu);
                else if (row0 < 12288) ((bf16*)(ws + WS_GR))[(size_t)pos * GVW + (row0 - 10240) + i] = (bf16)(pk2(siluf_fast(v), 0.f) & 0xffffu);
                else ((float*)(ws + WS_SM))[(size_t)pos * 32 + (row0 - 12288) + i] = v; } }
        else { const int tb = b - NB_TAIL; float v0, v1;
            skinny_tile<2>(F, a2 + (size_t)(16 * tb) * DM, DM, WINi + (size_t)WIN_SMALL * DM, WINi + (size_t)(WIN_SMALL + 16) * DM, DM, DM, v0, v1);
            if (F.tid < 256) { const int i = 4 * (F.tid >> 6) + (F.tid & 3), j = (F.tid >> 2) & 15, pos = 16 * tb + j; const float s = rstd_of(SS, pos);
                float* SMp = (float*)(ws + WS_SM) + (size_t)pos * 32; SMp[i] = v0 * s; SMp[16 + i] = v1 * s; } } }
    { const size_t gt = (size_t)blockIdx.x * 512 + F.tid, NTH = (size_t)F.G * 512; constexpr int PADR = LP - L;
      for (size_t e = gt; e < (size_t)3 * FOXH * PADR * (FOXD / 8); e += NTH) { const int c8 = (int)(e % (FOXD / 8)); const size_t rr = e / (FOXD / 8); const int pr = (int)(rr % PADR); const int th = (int)(rr / PADR);
          *(v4u*)((bf16*)(ws + WS_FQ) + ((size_t)th * LP + L + pr) * FOXD + 8 * c8) = (v4u){0u, 0u, 0u, 0u}; }
      for (size_t e = gt; e < (size_t)PADR * 32; e += NTH) ((float*)(ws + WS_SM))[(size_t)L * 32 + e] = 0.f; }
    __syncthreads();
}

__device__ __forceinline__ void skinny_gates(Frame& F) {
    unsigned char* ws = F.ws; const unsigned char* A8 = ws + WS_A8; const unsigned char* WG8 = ws + WS_WG8; const float* rs = (const float*)(ws + WS_RS2); const float* wmax = (const float*)(ws + WS_WCLIP) + WCH_G;
    for (int b = (int)blockIdx.x; b < 512; b += F.G) { const int row0 = 16 * b; float v;
        float dummy; skinny_tile8<1>(F, A8 + (size_t)TAIL0 * DM, WG8 + (size_t)row0 * DM, WG8, DM, v, dummy);
        if (F.tid < 256) { const int i = 4 * (F.tid >> 6) + (F.tid & 3), j = (F.tid >> 2) & 15, pos = TAIL0 + j; v *= rs[pos] * wmax[row0 + i] * (1.0f / 127.0f);
            const int t = row0 >> 8, within = row0 & 255; bf16* G = (bf16*)(ws + (within < 128 ? WS_GA : WS_GB));
            G[(size_t)pos * DM + 128 * t + (within & 127) + i] = (bf16)(pk2(sigmoidf_fast(v), 0.f) & 0xffffu); } }
    __syncthreads();
}
__device__ __forceinline__ void quant_rows(Frame& F, const bf16* src, const ssq_t* ss, unsigned char* dst, float* rs, int nrows, int wv, int nwv) {
    const int lane = lane_id_fresh(); const int gw = (int)blockIdx.x * nwv + wv, NGW = F.G * nwv;
    for (int r = gw; r < nrows; r += NGW) { const v4u* sp = (const v4u*)(src + (size_t)r * DM) + lane; v4u w[8]; float am = 0.f;
#pragma unroll
        for (int j = 0; j < 8; ++j) { w[j] = sp[64 * j];
            am = fmaxf(am, fmaxf(fmaxf(fabsf(bf_lo(w[j].x)), fabsf(bf_hi(w[j].x))), fmaxf(fabsf(bf_lo(w[j].y)), fabsf(bf_hi(w[j].y)))));
            am = fmaxf(am, fmaxf(fmaxf(fabsf(bf_lo(w[j].z)), fabsf(bf_hi(w[j].z))), fmaxf(fabsf(bf_lo(w[j].w)), fabsf(bf_hi(w[j].w))))); }
#pragma unroll
        for (int o = 1; o < 64; o <<= 1) am = fmaxf(am, __shfl_xor(am, o));
        const float sc = am > 0.f ? 127.0f / am : 0.f;
        v2u* dp = (v2u*)(dst + (size_t)r * DM) + lane;
#pragma unroll
        for (int j = 0; j < 8; ++j) { v2u o; o.x = pack4_i8(bf_lo(w[j].x) * sc, bf_hi(w[j].x) * sc, bf_lo(w[j].y) * sc, bf_hi(w[j].y) * sc); o.y = pack4_i8(bf_lo(w[j].z) * sc, bf_hi(w[j].z) * sc, bf_lo(w[j].w) * sc, bf_hi(w[j].w) * sc);
            dp[64 * j] = o; }
        if (lane == 0) rs[r] = am * (1.0f / 127.0f) * rstd_of(ss, r); }
}

__device__ __forceinline__ void prep_fox_cumsum(Frame& F, const Args& A, int h) {
    const float* lf = (const float*)(F.ws + WS_SM) + h; float* cb = (float*)(F.ws + WS_CB) + (size_t)h * LP;
    LAS float* wsum = (LAS float*)(F.lds + RING_OFF);
    const int base = 17 * F.tid; float v[17]; float run = 0.f; const float fb = A.in[I_FBIAS][h];
#pragma unroll
    for (int j = 0; j < 17; ++j) { const int idx = base + j; const float t = idx < LP ? log_sigmoidf_acc(lf[(size_t)idx * 32] + fb) : 0.f; run += t; v[j] = run; }
    float inc = run;
#pragma unroll
    for (int o = 1; o < 64; o <<= 1) { const float t = __shfl_up(inc, o); if (F.lane >= o) inc += t; }
    if (F.lane == 63) wsum[F.wave] = inc;
    __syncthreads();
    float pre = inc - run;
    for (int w = 0; w < F.wave; ++w) pre += wsum[w];
    constexpr float INVS = -11.313708498984761f;
#pragma unroll
    for (int j = 0; j < 17; ++j) { const int idx = base + j; if (idx < LP) cb[idx] = (pre + v[j]) * INVS; }
    __syncthreads();
}
__device__ __forceinline__ void prep_gla_item(Frame& F, const Args& A, int ci, int h, int parts) {
    const float* SMd = (const float*)(F.ws + WS_SM) + 16; const bf16* GK = (const bf16*)(F.ws + WS_GK); const bf16* GV = (const bf16*)(F.ws + WS_GV);
    bf16* KDT = (bf16*)(F.ws + WS_KDT) + (size_t)(h * NCHUNK + ci) * GDK * CHUNK; bf16* VT = (bf16*)(F.ws + WS_VT) + (size_t)(h * NCHUNK + ci) * GDV * CHUNK;
    float* GG = (float*)(F.ws + WS_GG) + (size_t)(ci * GLAH + h) * GDK;
    LAS float* abl = (LAS float*)(F.lds + RING_OFF);
    LAS float* tot = abl + 1024;
    const int p0 = ci * CHUNK - PADL;
    const int k = F.tid & 255, half = F.tid >> 8, kg = h * GDK + k;
    unsigned vr[64], kr[32]; float w[16], ab0 = 0.f, ab1 = 0.f, bb = 0.f;
    if (parts & 2) {
#pragma unroll
        for (int c = 0; c < 64; ++c) { const int p = p0 + c; vr[c] = GV[(size_t)(p < 0 ? 0 : p) * GVW + h * GDV + F.tid]; } }
    if (parts & 1) {
        { const int c = F.tid >> 4, p = p0 + c; ab0 = SMd[(size_t)(p < 0 ? 0 : p) * 32 + (F.tid & 15)]; if (p < 0) ab0 = 0.f; }
        { const int c = 32 + (F.tid >> 4), p = p0 + c; ab1 = SMd[(size_t)(p < 0 ? 0 : p) * 32 + (F.tid & 15)]; if (p < 0) ab1 = 0.f; }
#pragma unroll
        for (int r = 0; r < 16; ++r) w[r] = A.in[I_AW2][(size_t)r * GKW + kg];
        bb = A.in[I_AB][kg];
#pragma unroll
        for (int cc = 0; cc < 32; ++cc) { const int p = p0 + 32 * half + cc; kr[cc] = GK[(size_t)(p < 0 ? 0 : p) * GKW + kg]; } }
    if (parts & 1) {
    abl[F.tid] = ab0; abl[F.tid + 512] = ab1;
    __syncthreads();
    float cum[32]; float run = 0.f;
#pragma unroll
    for (int cc = 0; cc < 32; ++cc) { const int c = 32 * half + cc; float z = bb;
#pragma unroll
        for (int r4 = 0; r4 < 4; ++r4) { const f32x4 a4 = *(const LAS f32x4*)(abl + c * 16 + 4 * r4); z += a4[0] * w[4 * r4] + a4[1] * w[4 * r4 + 1] + a4[2] * w[4 * r4 + 2] + a4[3] * w[4 * r4 + 3]; }
        const float la = (p0 + c >= 0) ? log_sigmoidf_fast(z) * 0.0625f : 0.f; run += la; cum[cc] = run; }
    tot[half * 256 + k] = run;
    __syncthreads();
    const float t0 = tot[k], t1 = tot[256 + k], rem = half ? t1 : t0 + t1;
    if (half == 0) GG[k] = expf_fast(t0 + t1);
    unsigned pk[16];
#pragma unroll
    for (int cc = 0; cc < 32; cc += 2) { const int c = 32 * half + cc;
        const float k0v = (p0 + c >= 0) ? __uint_as_float(kr[cc] << 16) : 0.f, k1v = (p0 + c + 1 >= 0) ? __uint_as_float(kr[cc + 1] << 16) : 0.f;
        pk[cc >> 1] = pk2(k0v * expf_fast(rem - cum[cc]), k1v * expf_fast(rem - cum[cc + 1])); }
    { v4u* dst = (v4u*)(KDT + (size_t)k * CHUNK + 32 * half);
#pragma unroll
      for (int q = 0; q < 4; ++q) { v4u o; o.x = pk[4 * q]; o.y = pk[4 * q + 1]; o.z = pk[4 * q + 2]; o.w = pk[4 * q + 3]; dst[q] = o; } }
    }
    if (parts & 2) { unsigned pv[32];
#pragma unroll
      for (int c = 0; c < 64; c += 2) { const unsigned lo = (p0 + c >= 0) ? vr[c] : 0u, hi = (p0 + c + 1 >= 0) ? vr[c + 1] : 0u; pv[c >> 1] = lo | (hi << 16); }
      v4u* dst = (v4u*)(VT + (size_t)F.tid * CHUNK);
#pragma unroll
      for (int q = 0; q < 8; ++q) { v4u o; o.x = pv[4 * q]; o.y = pv[4 * q + 1]; o.z = pv[4 * q + 2]; o.w = pv[4 * q + 3]; dst[q] = o; } }
    __syncthreads();
}

__device__ __forceinline__ void sub_bar4(volatile LAS unsigned* ctr, unsigned& phase, int lane) {
    __builtin_amdgcn_fence(__ATOMIC_RELEASE, "workgroup");
    ++phase;
    if (lane == 0) (void)__hip_atomic_fetch_add((LAS unsigned*)ctr, 1u, __ATOMIC_RELAXED, __HIP_MEMORY_SCOPE_WORKGROUP);
    while (*ctr < 4u * phase) __builtin_amdgcn_s_sleep(1);
    __builtin_amdgcn_fence(__ATOMIC_ACQUIRE, "workgroup");
}
__device__ __forceinline__ void prep_gla_item4(Frame& F, const Args& A, int ci, int h, int buf, unsigned& phase) {
    const float* SMd = (const float*)(F.ws + WS_SM) + 16; const bf16* GK = (const bf16*)(F.ws + WS_GK); const bf16* GV = (const bf16*)(F.ws + WS_GV);
    bf16* KDT = (bf16*)(F.ws + WS_KDT) + (size_t)(h * NCHUNK + ci) * GDK * CHUNK; bf16* VT = (bf16*)(F.ws + WS_VT) + (size_t)(h * NCHUNK + ci) * GDV * CHUNK;
    float* GG = (float*)(F.ws + WS_GG) + (size_t)(ci * GLAH + h) * GDK;
    LAS float* abl = (LAS float*)(F.lds + RING_OFF) + buf * 1024;
    const int p0 = ci * CHUNK - PADL, t = F.tid, kg = h * GDK + t, lane = t & 63;
    float ab[4], w[16]; unsigned kr[64];
#pragma unroll
    for (int q = 0; q < 4; ++q) { const int i = t + 256 * q, p = p0 + (i >> 4); ab[q] = SMd[(size_t)(p < 0 ? 0 : p) * 32 + (i & 15)]; if (p < 0) ab[q] = 0.f; }
#pragma unroll
    for (int r = 0; r < 16; ++r) w[r] = A.in[I_AW2][(size_t)r * GKW + kg];
    const float bb = A.in[I_AB][kg];
#pragma unroll
    for (int c = 0; c < 64; ++c) { const int p = p0 + c; kr[c] = GK[(size_t)(p < 0 ? 0 : p) * GKW + kg]; }
#pragma unroll
    for (int q = 0; q < 4; ++q) abl[t + 256 * q] = ab[q];
    sub_bar4(F.MISC + 24, phase, lane);
    float cum[64]; float run = 0.f;
#pragma unroll
    for (int c = 0; c < 64; ++c) { float z = bb;
#pragma unroll
        for (int r4 = 0; r4 < 4; ++r4) { const f32x4 a4 = *(const LAS f32x4*)(abl + c * 16 + 4 * r4); z += a4[0] * w[4 * r4] + a4[1] * w[4 * r4 + 1] + a4[2] * w[4 * r4 + 2] + a4[3] * w[4 * r4 + 3]; }
        const float la = (p0 + c >= 0) ? log_sigmoidf_fast(z) * 0.0625f : 0.f; run += la; cum[c] = run; }
    GG[t] = expf_fast(run);
    { v4u* dst = (v4u*)(KDT + (size_t)t * CHUNK);
#pragma unroll
      for (int q = 0; q < 8; ++q) { unsigned pk[4];
#pragma unroll
          for (int e = 0; e < 4; ++e) { const int c = 8 * q + 2 * e;
              const float k0v = (p0 + c >= 0) ? __uint_as_float(kr[c] << 16) : 0.f, k1v = (p0 + c + 1 >= 0) ? __uint_as_float(kr[c + 1] << 16) : 0.f;
              pk[e] = pk2(k0v * expf_fast(run - cum[c]), k1v * expf_fast(run - cum[c + 1])); }
          v4u o; o.x = pk[0]; o.y = pk[1]; o.z = pk[2]; o.w = pk[3]; dst[q] = o; } }
#pragma unroll
    for (int vh = 0; vh < 2; ++vh) { const int v = t + 256 * vh; unsigned vr[64];
#pragma unroll
        for (int c = 0; c < 64; ++c) { const int p = p0 + c; vr[c] = GV[(size_t)(p < 0 ? 0 : p) * GVW + h * GDV + v]; }
        v4u* dst = (v4u*)(VT + (size_t)v * CHUNK);
#pragma unroll
        for (int q = 0; q < 8; ++q) { unsigned pv[4];
#pragma unroll
            for (int e = 0; e < 4; ++e) { const int c = 8 * q + 2 * e; const unsigned lo = (p0 + c >= 0) ? vr[c] : 0u, hi = (p0 + c + 1 >= 0) ? vr[c + 1] : 0u; pv[e] = lo | (hi << 16); }
            v4u o; o.x = pv[0]; o.y = pv[1]; o.z = pv[2]; o.w = pv[3]; dst[q] = o; } }
}

__device__ __forceinline__ void prep_fox_cumsum4(Frame& F, const Args& A, int h, unsigned& phase) {
    const float* lf = (const float*)(F.ws + WS_SM) + h; float* cb = (float*)(F.ws + WS_CB) + (size_t)h * LP;
    LAS float* wsum = (LAS float*)(F.lds + RING_OFF + 8192);
    const int t = F.tid, lane = t & 63, base = 33 * t; float v[33]; float run = 0.f; const float fb = A.in[I_FBIAS][h];
#pragma unroll
    for (int j = 0; j < 33; ++j) { run += log_sigmoidf_acc(lf[(size_t)(base + j) * 32] + fb); v[j] = run; }
    float inc = run;
#pragma unroll
    for (int o = 1; o < 64; o <<= 1) { const float u = __shfl_up(inc, o); if (lane >= o) inc += u; }
    if (lane == 63) wsum[F.wave] = inc;
    sub_bar4(F.MISC + 24, phase, lane);
    float pre = inc - run;
    for (int w = 0; w < F.wave; ++w) pre += wsum[w];
    constexpr float INVS = -11.313708498984761f;
#pragma unroll
    for (int j = 0; j < 33; ++j) cb[base + j] = (pre + v[j]) * INVS;
}
__device__ __forceinline__ void prep_fox_norms(Frame& F, int item, int vtid) {
    const int rb = item % 33, th = item / 33, t = th & 1, h = th >> 1;
    const bf16* base = (const bf16*)(F.ws + (t == 0 ? WS_FQ : WS_FK)) + ((size_t)h * LP + (size_t)rb * 256) * FOXD;
    const v4u* rp = (const v4u*)(base + (size_t)(vtid >> 1) * FOXD + (vtid & 1) * 64); float s = 0.f;
#pragma unroll
    for (int q = 0; q < 8; ++q) { const v4u w = rp[q]; s += bf_lo(w.x) * bf_lo(w.x) + bf_hi(w.x) * bf_hi(w.x) + bf_lo(w.y) * bf_lo(w.y) + bf_hi(w.y) * bf_hi(w.y)
                                                        + bf_lo(w.z) * bf_lo(w.z) + bf_hi(w.z) * bf_hi(w.z) + bf_lo(w.w) * bf_lo(w.w) + bf_hi(w.w) * bf_hi(w.w); }
    s += __shfl_xor(s, 1);
#pragma unroll
    for (int o = 2; o < 64; o <<= 1) s = fmaxf(s, __shfl_xor(s, o));
    if (F.lane == 0) atomicMax(F.ctl + CW_QKN + 2 * h + t, __float_as_uint(s));
}

constexpr int GL_PITCH = 144, GL_KD_OFF = 0, GL_Q_OFF = 64 * GL_PITCH  , GL_VT_OFF = 2 * 64 * GL_PITCH  , GL_G_OFF = GL_VT_OFF + 256 * GL_PITCH  , GL_BUF = GL_G_OFF + 256  ;
static_assert(2 * GL_BUF <= RING_BYTES, "GLA LDS");
constexpr int GLA_WGS = 32;
__device__ __forceinline__ void gla_compute(LAS unsigned char* tb, f32x16 (&st)[2], bf16* OP, int p0, int w, int r32, int hi) {
    bf16x8 vt[4];
#pragma unroll
    for (int ks = 0; ks < 4; ++ks) vt[ks] = *(const LAS bf16x8*)(tb + GL_VT_OFF + (32 * w + r32) * GL_PITCH + (16 * ks + 8 * hi) * 2);
#pragma unroll
    for (int kb = 0; kb < 2; ++kb) {
#pragma unroll
        for (int gI = 0; gI < 4; ++gI) { const f32x4 gg = *(const LAS f32x4*)(tb + GL_G_OFF + (32 * kb + 8 * gI + 4 * hi) * 4);
            st[kb][4 * gI] *= gg[0]; st[kb][4 * gI + 1] *= gg[1]; st[kb][4 * gI + 2] *= gg[2]; st[kb][4 * gI + 3] *= gg[3]; }
#pragma unroll
        for (int ks = 0; ks < 4; ++ks) { const bf16x8 a = *(const LAS bf16x8*)(tb + GL_KD_OFF + (32 * kb + r32) * GL_PITCH + (16 * ks + 8 * hi) * 2);
            st[kb] = __builtin_amdgcn_mfma_f32_32x32x16_bf16(a, vt[ks], st[kb], 0, 0, 0); } }
    f32x16 oc[2];
#pragma unroll
    for (int r = 0; r < 16; ++r) { oc[0][r] = 0.f; oc[1][r] = 0.f; }
#pragma unroll
    for (int kb = 0; kb < 2; ++kb)
#pragma unroll
        for (int jj = 0; jj < 2; ++jj) { v4u bw; bw.x = pk2(st[kb][8 * jj], st[kb][8 * jj + 1]); bw.y = pk2(st[kb][8 * jj + 2], st[kb][8 * jj + 3]);
            bw.z = pk2(st[kb][8 * jj + 4], st[kb][8 * jj + 5]); bw.w = pk2(st[kb][8 * jj + 6], st[kb][8 * jj + 7]);
            const bf16x8 b = __builtin_bit_cast(bf16x8, bw);
#pragma unroll
            for (int cb = 0; cb < 2; ++cb) { const LAS unsigned char* qp = tb + GL_Q_OFF + (32 * cb + r32) * GL_PITCH + (32 * kb + 16 * jj + 4 * hi) * 2;
                const v2u a0 = *(const LAS v2u*)qp, a1 = *(const LAS v2u*)(qp + 16);
                const v4u aw = {a0.x, a0.y, a1.x, a1.y};
                oc[cb] = __builtin_amdgcn_mfma_f32_32x32x16_bf16(__builtin_bit_cast(bf16x8, aw), b, oc[cb], 0, 0, 0); } }
#pragma unroll
    for (int cb = 0; cb < 2; ++cb)
#pragma unroll
        for (int r = 0; r < 16; ++r) { const int p = p0 + 32 * cb + (r & 3) + 8 * (r >> 2) + 4 * hi;
            if (p >= 0) OP[(size_t)p * GVW] = (bf16)(pk2(oc[cb][r], 0.f) & 0xffffu); }
}
__device__ __forceinline__ void gla_chain(Frame& F, int g) {
    const int h = g & 3, kq = (g >> 2) & 3, vh = g >> 4, lane = F.lane, r32 = lane & 31, hi = lane >> 5, tid = F.tid, w = F.wave;
    const char* KDb = (const char*)((const bf16*)(F.ws + WS_KDT) + ((size_t)h * NCHUNK * GDK + 64 * kq) * CHUNK);
    const char* VTb = (const char*)((const bf16*)(F.ws + WS_VT) + ((size_t)h * NCHUNK * GDV + 256 * vh) * CHUNK);
    const char* Qb = (const char*)((const bf16*)(F.ws + WS_GQ) + h * GDK + 64 * kq);
    const char* Gb = (const char*)((const float*)(F.ws + WS_GG) + h * GDK + 64 * kq);
    bf16* OP = (bf16*)(F.ws + WS_OPART) + (size_t)kq * LP * GVW + h * GDV + 256 * vh + 32 * w + r32;
    LAS unsigned char* lds = F.lds + RING_OFF;
    f32x16 st[2];
#pragma unroll
    for (int r = 0; r < 16; ++r) { st[0][r] = 0.f; st[1][r] = 0.f; }
    v4u kdA, qA, vA[4], kdB, qB, vB[4], kdC, qC, vC[4]; float gA, gB, gC;
#define GL_LOAD(ci, KD_, Q_, V_, G_) do { const int ci_ = (ci) < NCHUNK ? (ci) : NCHUNK - 1; int p_ = ci_ * CHUNK - PADL + (tid >> 3); p_ = p_ < 0 ? 0 : p_; \
        KD_ = *(const v4u*)(KDb + (size_t)ci_ * (GDK * CHUNK * 2) + (unsigned)(tid * 16)); \
        Q_ = *(const v4u*)(Qb + (size_t)p_ * (GKW * 2) + (unsigned)((tid & 7) * 16)); \
        _Pragma("unroll") for (int j = 0; j < 4; ++j) V_[j] = *(const v4u*)(VTb + (size_t)ci_ * (GDV * CHUNK * 2) + (unsigned)(tid * 16 + j * 8192)); \
        G_ = *(const float*)(Gb + (size_t)ci_ * (GLAH * GDK * 4) + (unsigned)((tid & 63) * 4)); } while (0)
#define GL_STORE_LDS(bo, KD_, Q_, V_, G_) do { \
        *(LAS v4u*)(lds + (bo) + GL_KD_OFF + (tid >> 3) * GL_PITCH + (tid & 7) * 16) = KD_; \
        *(LAS v4u*)(lds + (bo) + GL_Q_OFF + (tid >> 3) * GL_PITCH + (tid & 7) * 16) = Q_; \
        _Pragma("unroll") for (int j = 0; j < 4; ++j) { const int q = tid + 512 * j; *(LAS v4u*)(lds + (bo) + GL_VT_OFF + (q >> 3) * GL_PITCH + (q & 7) * 16) = V_[j]; } \
        *(LAS float*)(lds + (bo) + GL_G_OFF + 4 * (tid & 63)) = G_; } while (0)
#define GL_BAR() asm volatile("s_waitcnt lgkmcnt(0)\n\ts_barrier" ::: "memory")
#define GL_STEP(ci, KDn_, Qn_, Vn_, Gn_, KDf_, Qf_, Vf_, Gf_) do { \
        GL_BAR(); \
        GL_LOAD((ci) + 3, KDf_, Qf_, Vf_, Gf_); \
        __builtin_amdgcn_sched_barrier(0); \
        GL_STORE_LDS((((ci) + 1) & 1) * GL_BUF, KDn_, Qn_, Vn_, Gn_); \
        __builtin_amdgcn_sched_barrier(0); \
        gla_compute(lds + ((ci) & 1) * GL_BUF, st, OP, (ci) * CHUNK - PADL, w, r32, hi); } while (0)
    GL_LOAD(0, kdA, qA, vA, gA); GL_LOAD(1, kdB, qB, vB, gB); GL_LOAD(2, kdC, qC, vC, gC);
    GL_STORE_LDS(0, kdA, qA, vA, gA);
    static_assert(NCHUNK % 3 == 0, "three rotating register sets");
    for (int ci = 0; ci < NCHUNK; ci += 3) {
        GL_STEP(ci,     kdB, qB, vB, gB, kdA, qA, vA, gA);
        GL_STEP(ci + 1, kdC, qC, vC, gC, kdB, qB, vB, gB);
        GL_STEP(ci + 2, kdA, qA, vA, gA, kdC, qC, vC, gC); }
    __syncthreads();
#undef GL_LOAD
#undef GL_STORE_LDS
#undef GL_STEP
#undef GL_BAR
}

__device__ __forceinline__ fox::BlockRef fox_ref(Frame& F, int item) {
    const int qb = 32 - item / FOXH, h = item % FOXH; fox::BlockRef r;
    r.Q = (const bf16*)(F.ws + WS_FQ) + ((size_t)h * LP + (size_t)qb * fox::QB) * FOXD; r.K = (const bf16*)(F.ws + WS_FK) + (size_t)h * LP * FOXD; r.V = (const bf16*)(F.ws + WS_FV) + (size_t)h * LP * FOXD;
    r.O = (bf16*)(F.ws + WS_OAB) + (size_t)qb * fox::QB * DM + h * FOXD; r.P0 = qb * fox::QB; r.jlo = 0; return r;
}
__device__ __forceinline__ int fox_grab(Frame& F, int slot, int qw) {
    if (F.tid == 0) F.MISC[16 + slot] = __hip_atomic_fetch_add(F.ctl + CW_QUEUE + qw, 1u, RLX_AGENT);
    __syncthreads();
    return (int)F.MISC[16 + slot];
}
__device__ __forceinline__ void fox_phase(Frame& F, int qw) {
    constexpr int NITEMS = 33 * FOXH;
    char* lds = (char*)F.ldsg + RING_OFF;
    int item = fox_grab(F, 0, qw); if (item >= NITEMS) return;
    fox::BlockRef cur = fox_ref(F, item); fox::Seam S;
    fox::fox_prime(cur, lds, S);
    int slot = 1;
    for (;;) {
        { const float* cbg = (const float*)(F.ws + WS_CB) + (size_t)(item % FOXH) * LP; const unsigned* qkb = F.ctl + CW_QKN + 2 * (item % FOXH); const float qk[2] = {sqrtf(__uint_as_float(qkb[0])) * 1.001f, sqrtf(__uint_as_float(qkb[1])) * 1.001f};
          const int NTK = cur.P0 / fox::KVBLK + 4; const float th = cbg[cur.P0] - 110.0f * 11.313708498984761f - 2.0f * qk[0] * qk[1];
          int ln, tt; asm volatile("v_mov_b32 %0, %2\n\tv_mov_b32 %1, %3" : "=v"(ln), "=v"(tt) : "v"(F.lane), "v"(F.tid));
          int cnt = 0;
#pragma unroll
          for (int i = 0; i < 3; ++i) { const int j = ln + 64 * i; const bool pred = j < NTK && cbg[64 * (j < NTK ? j : 0) + 63] < th; cnt += __popcll(__ballot(pred)); }
          cur.jlo = __builtin_amdgcn_readfirstlane(cnt);
          float* cbl = (float*)(lds + fox::CB_OFF); const int i0 = 16 * cur.jlo, n4 = (cur.P0 + fox::QB) / 4;
          for (int i = i0 + tt; i < n4; i += 512) ((f32x4*)cbl)[i] = ((const f32x4*)cbg)[i]; }
        const int nitem = fox_grab(F, slot, qw); slot ^= 1;
        const bool last = nitem >= NITEMS;
        const fox::BlockRef nxt = last ? cur : fox_ref(F, nitem);
        fox::fox_block(cur, nxt, lds, S);
        if (last) break;
        cur = nxt; item = nitem;
    }
}

__device__ __forceinline__ void gla_norm_phase(Frame& F, const Args& A) {
    const bf16* OPa = (const bf16*)(F.ws + WS_OPART); const bf16* GR = (const bf16*)(F.ws + WS_GR); bf16* OAB = (bf16*)(F.ws + WS_OAB);
    const int gw = (int)blockIdx.x * NWAVES + F.wave, NGW = F.G * NWAVES;
    for (int it = gw; it < SEQ * GLAH; it += NGW) { const int pos = NMETA + (it >> 2), h = it & 3;
        float o[8] = {0.f, 0.f, 0.f, 0.f, 0.f, 0.f, 0.f, 0.f};
#pragma unroll
        for (int kq = 0; kq < 4; ++kq) { const v4u pw = *(const v4u*)(OPa + ((size_t)kq * LP + pos) * GVW + h * GDV + 8 * F.lane);
            o[0] += bf_lo(pw.x); o[1] += bf_hi(pw.x); o[2] += bf_lo(pw.y); o[3] += bf_hi(pw.y); o[4] += bf_lo(pw.z); o[5] += bf_hi(pw.z); o[6] += bf_lo(pw.w); o[7] += bf_hi(pw.w); }
        const float ssq = wave_sum((o[0] * o[0] + o[1] * o[1]) + (o[2] * o[2] + o[3] * o[3]) + (o[4] * o[4] + o[5] * o[5]) + (o[6] * o[6] + o[7] * o[7]));
        const float rstd = 1.0f / sqrtf(ssq * (1.f / GDV) + EPS);
        const f32x4 g0 = *(const f32x4*)(A.in[I_GNG] + 8 * F.lane), g1 = *(const f32x4*)(A.in[I_GNG] + 8 * F.lane + 4);
        const v4u rw = *(const v4u*)(GR + (size_t)pos * GVW + h * GDV + 8 * F.lane);
        v4u wv; wv.x = pk2(o[0] * rstd * g0[0] * bf_lo(rw.x), o[1] * rstd * g0[1] * bf_hi(rw.x)); wv.y = pk2(o[2] * rstd * g0[2] * bf_lo(rw.y), o[3] * rstd * g0[3] * bf_hi(rw.y));
        wv.z = pk2(o[4] * rstd * g1[0] * bf_lo(rw.z), o[5] * rstd * g1[1] * bf_hi(rw.z)); wv.w = pk2(o[6] * rstd * g1[2] * bf_lo(rw.w), o[7] * rstd * g1[3] * bf_hi(rw.w));
        *(v4u*)(OAB + (size_t)pos * DM + FOXW + h * GDV + 8 * F.lane) = wv; }
}

constexpr int N_PHASES = 12;

__global__ void __launch_bounds__(NWAVES * 64, 2) mk_fwd(Args args) {
    extern __shared__ __attribute__((aligned(16))) unsigned char lds[];
    Frame F;
    F.lds = (LAS unsigned char*)lds; F.ldsg = lds;
    F.MISC = (volatile LAS unsigned*)(F.lds + MISC_OFF);
    F.tid = threadIdx.x; F.lane = F.tid & 63; F.wave = __builtin_amdgcn_readfirstlane(F.tid >> 6);
    F.G = gridDim.x;
    F.ws = args.ws; F.ctl = (unsigned*)(args.ws + WS_CTL);
    unsigned char* ws = args.ws;
    for (int u = F.tid; u < (LDS_BYTES - LDSCTL_OFF) / 4; u += NWAVES * 64) ((LAS unsigned*)(F.lds + LDSCTL_OFF))[u] = 0u;
    __syncthreads();
    XcdBarrier bar; bar.bar = F.ctl + CW_BAR; bar.x = 0; bar.st = nullptr;
    if (MK_N_LAUNCHES == 1) bar = xcd_barrier_post(F.ctl + CW_BAR, F.MISC + 8);
#define GRID_BAR() do { if (MK_N_LAUNCHES == 1) xcd_barrier(bar); } while (0)
    const int lo = args.ph_lo, hi = args.ph_hi;
#ifdef ONLY_PHASE
#define IN(k) ((k) == ONLY_PHASE && lo <= (k) && (k) < hi)
#else
#define IN(k) (lo <= (k) && (k) < hi)
#endif
#define SEAM(k) do { if (IN((k) + 1)) GRID_BAR(); } while (0)

#define W1A ((bf16*)(ws + WS_W1A))
#define W1B ((bf16*)(ws + WS_W1B))
#define WINb ((bf16*)(ws + WS_WIN))
#define WP ((bf16*)(ws + WS_WP))
#define WO ((bf16*)(ws + WS_WO))
#define W2A ((bf16*)(ws + WS_W2A))
#define W2B ((bf16*)(ws + WS_W2B))
#define ABUF ((bf16*)(ws + WS_ABUF))
#define HID ((bf16*)(ws + WS_HID))
#define H ((bf16*)(ws + WS_H))
#define GA ((bf16*)(ws + WS_GA))
#define GB ((bf16*)(ws + WS_GB))
#define OAB ((bf16*)(ws + WS_OAB))
#define Y ((bf16*)(ws + WS_Y))
#define YBF ((bf16*)(ws + WS_YBF))
#define A8G ((const bf16*)(ws + WS_A8))
#define WG8 ((const bf16*)(ws + WS_WG8))
#define RS2 ((const float*)(ws + WS_RS2))
#define WMAXG ((const float*)(ws + WS_WCLIP) + WCH_G)
#define SS2 ((ssq_t*)(F.ctl + CW_SS2))
#define SS3 ((ssq_t*)(F.ctl + CW_SS3))
#define SS4 ((ssq_t*)(F.ctl + CW_SS4))
    const int c = (int)blockIdx.x;

    if (IN(0)) { p0_prologue(F, args); SEAM(0); }
    if (IN(1)) { quantise_ffn1(F, args); GRID_BAR();
        skinny_p1(F, ws + WS_A8, (const float*)(ws + WS_RS1), ws + WS_W1A, (const float*)(ws + WS_WCLIP) + WCH_F1, HID);
        pg8::Gemm g{A8G, W1A, DM / 2, DM / 2, DM / 2}; pg8::GridOrder S; S.init(32, 86, F.G, c, 0, 0);
        EpiSwiGLUQ E{HID, (const float*)(ws + WS_RS1), (const float*)(ws + WS_WCLIP) + WCH_F1};
        pg8::gemm_phase<EpiSwiGLUQ, pg8::GridOrder, true, false, true>(F.lds + RING_OFF, g, S, E); SEAM(1); }
    if (IN(2)) { skinny_p2(F, args, HID, W1B, H, ABUF, SS2);
        pg8::Gemm g{HID, W1B, DFF, DFF, DFF}; pg8::GridOrder S; S.init(32, 16, F.G, c, 0, 0);
        EpiResid<0> E{args.in[I_X], args.in[I_META], H, nullptr, ABUF, args.in[I_NMIXG], SS2, 0.5f, H};
        pg8::gemm_phase<EpiResid<0>, pg8::GridOrder>(F.lds + RING_OFF, g, S, E); SEAM(2); }
    if (IN(3)) { skinny_p3(F, ABUF, WINb, SS2);
        pg8::Gemm g{ABUF, WINb, DM, DM, DM}; pg8::GridOrder S; S.init(32, 48, F.G, c, 0, 0); EpiWin E{SS2, ws};
        pg8::gemm_phase<EpiWin, pg8::GridOrder>(F.lds + RING_OFF, g, S, E); SEAM(3); }
    if (IN(4)) {
        if (F.wave >= 4) quantise_late(F, args, c, F.G, F.wave - 4, 4, RING_OFF + 16384, 0, 8);
        else { unsigned phase = 0u; int buf = 0;
            for (int it = c; it < NCHUNK * GLAH; it += F.G) { prep_gla_item4(F, args, it >> 2, it & 3, buf, phase); buf ^= 1; }
            for (int it = c; it < 2 * FOXH * 33; it += F.G) { prep_fox_norms(F, it, F.tid); prep_fox_norms(F, it, F.tid + 256); }
            if (c < FOXH) prep_fox_cumsum4(F, args, c, phase);
            quant_rows(F, ABUF, SS2, ws + WS_A8, (float*)(ws + WS_RS2), L, F.wave, 4); }
        __syncthreads();
        SEAM(4); }
    if (IN(5)) {
        const bool gla_role = c < 64 && (c & 7) < 4;
        const int gemm_idx = c < 64 ? (c >> 3) * 4 + ((c & 7) - 4) : c - 32;
        skinny_gates(F);
        if (gla_role) gla_chain(F, (c & 7) + 4 * (c >> 3));
        else { pg8::Gemm g{A8G, WG8, DM / 2, DM / 2, DM / 2}; pg8::GridOrder S; S.init(28, 32, F.G - GLA_WGS, gemm_idx, 0, 0); EpiGate E{RS2, WMAXG, GA, GB, 2};
               pg8::gemm_phase<EpiGate, pg8::GridOrder, true, false, true>(F.lds + RING_OFF, g, S, E); }
        { pg8::Gemm g{A8G, WG8, DM / 2, DM / 2, DM / 2}; HalfOrder S; S.c = c; EpiGate E{RS2, WMAXG, GA, GB, 1};
          pg8::gemm_phase<EpiGate, HalfOrder, true, true, true>(F.lds + RING_OFF, g, S, E); }
        fox_phase(F, 0);
        SEAM(5); }
    if (IN(6)) { gla_norm_phase(F, args); SEAM(6); }
    if (IN(7)) { pg8::Gemm g{OAB, WP, DM, DM, FOXW}; pg8::GridOrder S; S.init(32, 16, F.G, c, NMETA, 0);
        EpiProj<0> E{GA, Y, YBF};
        pg8::gemm_phase<EpiProj<0>, pg8::GridOrder>(F.lds + RING_OFF, g, S, E); SEAM(7); }
    if (IN(8)) { pg8::Gemm g{OAB + FOXW, WP + FOXW, DM, DM, GVW}; pg8::GridOrder S; S.init(32, 16, F.G, c, NMETA, 0);
        EpiProj<1> E{GB, Y, YBF};
        pg8::gemm_phase<EpiProj<1>, pg8::GridOrder>(F.lds + RING_OFF, g, S, E); SEAM(8); }
    if (IN(9)) { pg8::Gemm g{YBF, WO, DM, DM, DM}; PanelOrder S; S.G = F.G; S.c = c;
        EpiResidQ E{H, args.in[I_N2G], SS3, F.ctl + CW_AMAX3, ws + WS_A8, (float*)(ws + WS_RS3), F.ctl + CW_PANEL9, F.ctl + CW_BAR};
        pg8::gemm_phase<EpiResidQ, PanelOrder>(F.lds + RING_OFF, g, S, E); SEAM(9); }
    if (IN(10)) { pg8::Gemm g{A8G, W2A, DM / 2, DM / 2, DM / 2}; pg8::GridOrder S; S.init(32, 86, F.G, c, NMETA, 0);
        EpiSwiGLUQ E{HID, (const float*)(ws + WS_RS3), (const float*)(ws + WS_WCLIP) + WCH_F2};
        pg8::gemm_phase<EpiSwiGLUQ, pg8::GridOrder, true, false, true>(F.lds + RING_OFF, g, S, E); SEAM(10); }
    if (IN(11)) { pg8::Gemm g{HID, W2B, DFF, DFF, DFF}; PanelOrder S; S.G = F.G; S.c = c;
        EpiFinal E{H, args.out, args.in[I_NFG], SS4, F.ctl + CW_PANEL, F.ctl + CW_BAR, 0.5f};
        pg8::gemm_phase<EpiFinal, PanelOrder>(F.lds + RING_OFF, g, S, E); }
#undef A8G
#undef WG8
#undef RS2
#undef WMAXG
#undef IN
#undef SEAM
#undef GRID_BAR
#undef W1A
#undef W1B
#undef WINb
#undef WP
#undef WO
#undef W2A
#undef W2B
#undef ABUF
#undef HID
#undef H
#undef GA
#undef GB
#undef OAB
#undef Y
#undef YBF
#undef SS2
#undef SS3
#undef SS4
}

extern "C" void kernel_launch(void* const* d_in, const int* in_sizes, int n_in, void* d_out, int out_size, void* d_ws, size_t ws_size, hipStream_t stream) {
    static int grid = 0;
    if (grid == 0) {
        if (n_in != 21 || in_sizes[0] != SEQ * DM || out_size != SEQ * DM || ws_size < WS_END) {
            fprintf(stderr, "kernel_launch: shape / workspace mismatch (n_in %d, in0 %d, out %d, ws %zu < %zu?)\n", n_in, n_in > 0 ? in_sizes[0] : -1, out_size, ws_size, (size_t)WS_END); grid = -1; return; }
        int dev = 0, cus = 0, per_cu = 0;
        if (hipGetDevice(&dev) != hipSuccess || hipDeviceGetAttribute(&cus, hipDeviceAttributeMultiprocessorCount, dev) != hipSuccess) { fprintf(stderr, "kernel_launch: device query failed\n"); grid = -1; return; }
        if (hipFuncSetAttribute((const void*)mk_fwd, hipFuncAttributeMaxDynamicSharedMemorySize, LDS_BYTES) != hipSuccess) { fprintf(stderr, "kernel_launch: hipFuncSetAttribute failed\n"); grid = -1; return; }
        if (hipOccupancyMaxActiveBlocksPerMultiprocessor(&per_cu, (const void*)mk_fwd, NWAVES * 64, LDS_BYTES) != hipSuccess || per_cu < 1)
            fprintf(stderr, "kernel_launch: note: occupancy query reports %d workgroups per CU\n", per_cu);
        (void)hipGetLastError();
        grid = cus;
    }
    if (grid < 0) return;
    if (hipMemsetAsync((char*)d_ws + WS_CTL, 0, CTL_ZERO_BYTES, stream) != hipSuccess) { fprintf(stderr, "kernel_launch: memset failed\n"); return; }
    Args a{};
    for (int i = 0; i < 21; ++i) a.in[i] = (const float*)d_in[i];
    a.out = (float*)d_out; a.ws = (unsigned char*)d_ws;
    if (MK_N_LAUNCHES == 1) { a.ph_lo = 0; a.ph_hi = N_PHASES; hipLaunchKernelGGL(mk_fwd, dim3(grid), dim3(NWAVES * 64), LDS_BYTES, stream, a); }
    else for (int p = 0; p < N_PHASES; ++p) { a.ph_lo = p; a.ph_hi = p + 1; hipLaunchKernelGGL(mk_fwd, dim3(grid), dim3(NWAVES * 64), LDS_BYTES, stream, a); }
    const hipError_t le = hipPeekAtLastError();
    if (le != hipSuccess) fprintf(stderr, "kernel_launch: launch failed: %s\n", hipGetErrorName(le));
}
```

```cpp
#include <hip/hip_runtime.h>
#include <cstdio>
#include <cstdint>

#ifndef MK_N_LAUNCHES
#define MK_N_LAUNCHES 1
#endif

namespace pg8 {
#define PG8_LAS __attribute__((address_space(3)))
typedef unsigned short bf16_t;
typedef short bf16x8 __attribute__((ext_vector_type(8)));
typedef float f32x4 __attribute__((ext_vector_type(4)));
typedef unsigned u32x4 __attribute__((ext_vector_type(4)));
typedef unsigned u32x2 __attribute__((ext_vector_type(2)));
constexpr int BM = 256, BK = 64, HALF = 128, HTB = HALF * BK * 2  , STAGE_BYTES = 8 * HTB, NXCD = 8, WGM = 8;

__host__ __device__ __forceinline__ int lds_byte(int r, int c) { const int st = (r >> 4) * 2 + (c >> 5), rr = r & 15, cc = c & 31, ob = rr * 64 + cc * 2; return st * 1024 + (ob ^ (((ob >> 9) & 1) << 5)); }
__host__ __device__ __forceinline__ void stage_rc(int b, int& R, int& C) { const int st = b / 1024, sb = b % 1024, swz = sb ^ (((sb >> 9) & 1) << 5); R = (st >> 1) * 16 + swz / 64; C = (st & 1) * 32 + (swz % 64) / 2; }
__host__ __device__ __forceinline__ int perm32(int rho) { const int n = rho >> 4, i = rho & 15; return 8 * (i >> 2) + 4 * n + (i & 3); }

struct Unit { int arow, brow, pn; };
struct Gemm { const bf16_t* A; const bf16_t* Bt; int lda, ldb, K; };

typedef int i32x4 __attribute__((ext_vector_type(4)));
template <bool I8> struct AccSel { typedef f32x4 T; };
template <> struct AccSel<true> { typedef i32x4 T; };
struct GridOrder {
    int nM, nN, nwg, G, c, arow0, brow0;
    __device__ void init(int nM_, int nN_, int G_, int c_, int arow0_, int brow0_) { nM = nM_; nN = nN_; nwg = nM * nN; G = G_; c = c_; arow0 = arow0_; brow0 = brow0_; }
    __device__ bool next(int i, Unit& u) const {
        const long L = (long)i * G + c; if (L >= nwg) return false;
        int wgid = (int)L; { const int q = nwg / NXCD, r = nwg % NXCD, xcd = wgid % NXCD, off = wgid / NXCD; wgid = (xcd < r ? xcd * (q + 1) : r * (q + 1) + (xcd - r) * q) + off; }
        const int nig = WGM * nN, gid = wgid / nig, fm = gid * WGM, gsz = (nM - fm) < WGM ? (nM - fm) : WGM;
        const int pm = fm + ((wgid % nig) % gsz), pn = (wgid % nig) / gsz;
        u.arow = arow0 + pm * BM; u.brow = brow0 + pn * BM; u.pn = pn; return true;
    }
};

__device__ __forceinline__ unsigned cvt_pk_bf16(float lo, float hi) { unsigned r; asm volatile("v_cvt_pk_bf16_f32 %0, %1, %2" : "=v"(r) : "v"(lo), "v"(hi)); return r; }

template <class Epi, class Sched, bool ALIGN_EPI = true, bool MHALF = false, bool I8 = false>
__device__ __forceinline__ void gemm_phase(PG8_LAS unsigned char* lds, const Gemm g, const Sched& S, const Epi& E) {
    const int tid = threadIdx.x, wid = __builtin_amdgcn_readfirstlane(tid >> 6), lane = tid & 63, wr = wid >> 2, wc = wid & 3, fr = lane & 15, fq = lane >> 4;
    const int K = g.K, nt = K / BK;
    unsigned voffA[2], voffB[2];
#pragma unroll
    for (int i = 0; i < 2; ++i) { int R, C; stage_rc(tid * 16 + i * 8192, R, C); const int Rb = (R & ~31) + perm32(R & 31);
        voffA[i] = (unsigned)(R * g.lda + C) * 2u; voffB[i] = (unsigned)(Rb * g.ldb + C) * 2u; }
    const size_t kstep = (size_t)(BK * 2);
    const size_t hstepA = (size_t)HALF * g.lda * 2, hstepB = (size_t)HALF * g.ldb * 2;
    const unsigned ldsw = (unsigned)wid * 1024u;
    const int aoff = lds_byte(wr * 64 + fr, fq * 8), boff = lds_byte(wc * 32 + fr, fq * 8);
#define PG8_SA(b, h) (((b) * 2 + (h)) * HTB)
#define PG8_SB(b, h) ((4 + (b) * 2 + (h)) * HTB)
#define PG8_STAGE(bufoff, gbase, voff) do { _Pragma("unroll") for (int _i = 0; _i < 2; ++_i) \
        __builtin_amdgcn_global_load_lds((const unsigned*)((const char*)(gbase) + (voff)[_i]), (PG8_LAS unsigned*)(lds + (bufoff) + ldsw + _i * 8192), 16, 0, 0); } while (0)
#define PG8_LDA(dst, b, h) do { _Pragma("unroll") for (int m = 0; m < 4; ++m) _Pragma("unroll") for (int k = 0; k < 2; ++k) dst[m][k] = *(const PG8_LAS bf16x8*)(lds + PG8_SA(b, h) + aoff + m * 2048 + k * 1024); } while (0)
#define PG8_LDB(dst, b, h) do { _Pragma("unroll") for (int n = 0; n < 2; ++n) _Pragma("unroll") for (int k = 0; k < 2; ++k) dst[n][k] = *(const PG8_LAS bf16x8*)(lds + PG8_SB(b, h) + boff + n * 2048 + k * 1024); } while (0)
#define PG8_MMA(ai, bj, At, Bt) do { __builtin_amdgcn_s_setprio(1); _Pragma("unroll") for (int m = 0; m < 4; ++m) _Pragma("unroll") for (int n = 0; n < 2; ++n) _Pragma("unroll") for (int k = 0; k < 2; ++k) \
        { if constexpr (I8) acc[ai][bj][m][n] = __builtin_amdgcn_mfma_i32_16x16x64_i8(__builtin_bit_cast(i32x4, Bt[n][k]), __builtin_bit_cast(i32x4, At[m][k]), acc[ai][bj][m][n], 0, 0, 0); \
          else acc[ai][bj][m][n] = __builtin_amdgcn_mfma_f32_16x16x32_bf16(Bt[n][k], At[m][k], acc[ai][bj][m][n], 0, 0, 0); } __builtin_amdgcn_s_setprio(0); } while (0)
#define PG8_WAIT_V(n) asm volatile("s_waitcnt vmcnt(" #n ")" ::: "memory")
#define PG8_WAIT_L(n) asm volatile("s_waitcnt lgkmcnt(" #n ")" ::: "memory")
#define PG8_BAR __builtin_amdgcn_s_barrier()
#define PG8_SCHED __builtin_amdgcn_sched_barrier(0)
    Unit cur, nxt; int ui = 0;
    if (!S.next(0, cur)) return;
    typename AccSel<I8>::T acc[2][2][4][2];
#pragma unroll
    for (int a = 0; a < 2; ++a)
#pragma unroll
        for (int b = 0; b < 2; ++b)
#pragma unroll
            for (int m = 0; m < 4; ++m)
#pragma unroll
                for (int n = 0; n < 2; ++n) acc[a][b][m][n] = (typename AccSel<I8>::T){0, 0, 0, 0};
    bf16x8 At[4][2], B0[2][2], B1[2][2];
    const char* cA = (const char*)g.A + (size_t)cur.arow * g.lda * 2; const char* cB = (const char*)g.Bt + (size_t)cur.brow * g.ldb * 2;
    PG8_STAGE(PG8_SB(0, 0), cB, voffB); PG8_STAGE(PG8_SB(0, 1), cB + hstepB, voffB); PG8_STAGE(PG8_SA(0, 0), cA, voffA); PG8_STAGE(PG8_SA(0, 1), cA + hstepA, voffA);
    if (wr == 1) PG8_BAR;
    PG8_WAIT_V(2); PG8_BAR;
    PG8_STAGE(PG8_SB(1, 0), cB + kstep, voffB); PG8_STAGE(PG8_SA(1, 0), cA + kstep, voffA); PG8_STAGE(PG8_SB(1, 1), cB + hstepB + kstep, voffB);
    PG8_WAIT_V(6); PG8_BAR;
    for (;;) {
        const bool has_next = S.next(ui + 1, nxt);
        const char* nA = has_next ? (const char*)g.A + (size_t)nxt.arow * g.lda * 2 : cA; const char* nB = has_next ? (const char*)g.Bt + (size_t)nxt.brow * g.ldb * 2 : cB;
        for (int t = 0; t < nt; t += 2) {
            const bool last = (t == nt - 2);
            const char* a1 = cA + (size_t)(t + 1) * kstep;
            const char* a2 = last ? nA : cA + (size_t)(t + 2) * kstep; const char* b2 = last ? nB : cB + (size_t)(t + 2) * kstep;
            const char* a3 = a2 + kstep; const char* b3 = b2 + kstep;
            PG8_LDB(B0, 0, 0); PG8_LDB(B1, 0, 1); PG8_SCHED; PG8_LDA(At, 0, 0); PG8_STAGE(PG8_SA(1, 1), a1 + hstepA, voffA);
            PG8_WAIT_V(8); PG8_WAIT_L(0); PG8_BAR; PG8_MMA(0, 0, At, B0); PG8_MMA(0, 1, At, B1); PG8_BAR; PG8_SCHED;
            if (!MHALF) PG8_LDA(At, 0, 1); PG8_STAGE(PG8_SB(0, 0), b2, voffB); PG8_STAGE(PG8_SB(0, 1), b2 + hstepB, voffB); PG8_STAGE(PG8_SA(0, 0), a2, voffA);
            PG8_WAIT_V(8); PG8_WAIT_L(0); PG8_BAR; if (!MHALF) { PG8_MMA(1, 0, At, B0); PG8_MMA(1, 1, At, B1); } PG8_BAR; PG8_SCHED;
            PG8_LDB(B0, 1, 0); PG8_LDB(B1, 1, 1); PG8_SCHED; PG8_LDA(At, 1, 0); PG8_STAGE(PG8_SA(0, 1), a2 + hstepA, voffA);
            PG8_WAIT_V(8); PG8_WAIT_L(0); PG8_BAR; PG8_MMA(0, 0, At, B0); PG8_MMA(0, 1, At, B1); PG8_BAR; PG8_SCHED;
            if (!MHALF) PG8_LDA(At, 1, 1); PG8_STAGE(PG8_SB(1, 0), b3, voffB); PG8_STAGE(PG8_SB(1, 1), b3 + hstepB, voffB); PG8_STAGE(PG8_SA(1, 0), a3, voffA);
            PG8_WAIT_V(8); PG8_WAIT_L(0); PG8_BAR; if (!MHALF) { PG8_MMA(1, 0, At, B0); PG8_MMA(1, 1, At, B1); } PG8_BAR; PG8_SCHED;
        }
        if constexpr (ALIGN_EPI) { if (wr == 0) PG8_BAR; }
        if constexpr (I8) { f32x4 accf[2][2][4][2];
#pragma unroll
            for (int a = 0; a < 2; ++a)
#pragma unroll
                for (int b = 0; b < 2; ++b)
#pragma unroll
                    for (int m = 0; m < 4; ++m)
#pragma unroll
                        for (int n = 0; n < 2; ++n) accf[a][b][m][n] = __builtin_convertvector(acc[a][b][m][n], f32x4);
            E(accf, cur, wr, wc, fr, fq); }
        else E(acc, cur, wr, wc, fr, fq);
        if (!has_next) break;
#pragma unroll
        for (int a = 0; a < 2; ++a)
#pragma unroll
            for (int b = 0; b < 2; ++b)
#pragma unroll
                for (int m = 0; m < 4; ++m)
#pragma unroll
                    for (int n = 0; n < 2; ++n) acc[a][b][m][n] = (typename AccSel<I8>::T){0, 0, 0, 0};
        cur = nxt; cA = nA; cB = nB; ++ui;
        if constexpr (ALIGN_EPI) { if (wr == 1) PG8_BAR; }
    }
    PG8_WAIT_V(0);
    if constexpr (!ALIGN_EPI) { if (wr == 0) PG8_BAR; }
    PG8_BAR;
#undef PG8_SA
#undef PG8_SB
#undef PG8_STAGE
#undef PG8_LDA
#undef PG8_LDB
#undef PG8_MMA
#undef PG8_WAIT_V
#undef PG8_WAIT_L
#undef PG8_BAR
#undef PG8_SCHED
}
}

namespace fox {
typedef unsigned short bf16;
typedef short bf16x8 __attribute__((ext_vector_type(8)));
typedef short s16x4 __attribute__((ext_vector_type(4)));
typedef float f32x16 __attribute__((ext_vector_type(16)));
typedef float f32x4 __attribute__((ext_vector_type(4)));
typedef unsigned u32x4 __attribute__((ext_vector_type(4)));
constexpr int D = 128;
constexpr float SCALE = 0.08838834764831845f;
constexpr float THR = 8.f;
constexpr int NW = 8, QBLK = 32, KVBLK = 64, QB = NW * QBLK;
constexpr int SHM_V = KVBLK * D * 2, SHM_K = KVBLK * D * 2;
constexpr int LDS_CORE = 2 * SHM_V + 2 * SHM_K + NW * 64 * 4;
constexpr int CB_OFF = 69632;
constexpr int OSTRIDE = 4096;

#define KSWZ(row, colB) ((row) * 256 + ((colB) ^ (((row) & 7) << 4)))
#define SBAR() __builtin_amdgcn_sched_barrier(0)
__device__ __forceinline__ int v_st(int k, int c) { const int kk = (k & ~0xC) | ((k & 4) << 1) | ((k & 8) >> 1); return ((kk >> 3) * 4 + (c >> 5)) * 512 + ((kk & 7) * 32 + (c & 31)) * 2; }
__device__ __forceinline__ int v_rd_base(int lane) { return ((lane & 3) << 3) | (((lane >> 2) & 3) << 6) | (((lane >> 4) & 1) << 5) | (((lane >> 5) & 1) << 8); }
constexpr int v_rd_off(int d0, int ks, int half) { return d0 * 512 + ks * 4096 + half * 2048; }
__device__ __forceinline__ int crow(int r, int hi) { return (r & 3) + 8 * (r >> 2) + 4 * hi; }
__device__ __forceinline__ unsigned cvtpk(float lo, float hi) { unsigned r; asm volatile("v_cvt_pk_bf16_f32 %0, %1, %2" : "=v"(r) : "v"(lo), "v"(hi)); return r; }
__device__ __forceinline__ bf16x8 load8(const bf16* p) { return *reinterpret_cast<const bf16x8*>(p); }
__device__ __forceinline__ void mask_tile(f32x16& p0, f32x16& p1, int dq) {
    const float NEG = -__builtin_inff();
#pragma unroll
    for (int r = 0; r < 16; ++r) {
        const int c = (r & 3) + 8 * (r >> 2);
        if (dq - c < 0) p0[r] = NEG;
        if (dq - c - 32 < 0) p1[r] = NEG;
    }
}
__device__ __forceinline__ void partialSM(f32x16& p0, f32x16& p1, float& m_reg, float& mn, float& alpha) {
    float pmax = p0[0];
#pragma unroll
    for (int r = 1; r < 16; ++r) pmax = fmaxf(pmax, p0[r]);
#pragma unroll
    for (int r = 0; r < 16; ++r) pmax = fmaxf(pmax, p1[r]);
    { auto rr = __builtin_amdgcn_permlane32_swap(__float_as_uint(pmax), __float_as_uint(pmax), false, false);
      pmax = fmaxf(__uint_as_float(rr[0]), __uint_as_float(rr[1])); }
    constexpr float C2 = 1.4426950408889634f * SCALE;
    if (__builtin_expect(__all((pmax - m_reg) * SCALE <= THR), 1)) { mn = m_reg; alpha = 1.f; }
    else { mn = fmaxf(m_reg, pmax); alpha = __builtin_amdgcn_exp2f((m_reg - mn) * C2); m_reg = mn; }
    const float mnL = -mn * C2;
#pragma unroll
    for (int r = 0; r < 16; ++r) p0[r] = fmaf(p0[r], C2, mnL);
#pragma unroll
    for (int r = 0; r < 16; ++r) p1[r] = fmaf(p1[r], C2, mnL);
#pragma unroll
    for (int r = 0; r < 16; ++r) p0[r] = __builtin_amdgcn_exp2f(p0[r]);
}
__device__ __forceinline__ void finishSM(f32x16& p0, f32x16& p1, float alpha, float& l_reg, bf16x8& pa0, bf16x8& pa1, bf16x8& pa2, bf16x8& pa3) {
#pragma unroll
    for (int r = 0; r < 16; ++r) p1[r] = __builtin_amdgcn_exp2f(p1[r]);
    float ps = 0;
#pragma unroll
    for (int r = 0; r < 16; ++r) ps += p0[r];
#pragma unroll
    for (int r = 0; r < 16; ++r) ps += p1[r];
    { auto rr = __builtin_amdgcn_permlane32_swap(__float_as_uint(ps), __float_as_uint(ps), false, false);
      ps = __uint_as_float(rr[0]) + __uint_as_float(rr[1]); }
    l_reg = l_reg * alpha + ps;
#define PK4(P, B_, OUT) do { unsigned a0 = cvtpk(P[B_+0], P[B_+1]), a1 = cvtpk(P[B_+2], P[B_+3]);                          \
        unsigned b0 = cvtpk(P[B_+4], P[B_+5]), b1 = cvtpk(P[B_+6], P[B_+7]);                                             \
        auto r0 = __builtin_amdgcn_permlane32_swap(a0, b0, false, false); auto r1 = __builtin_amdgcn_permlane32_swap(a1, b1, false, false); \
        u32x4 w = {r0[0], r1[0], r0[1], r1[1]}; OUT = *reinterpret_cast<bf16x8*>(&w); } while (0)
    PK4(p0, 0, pa0); PK4(p0, 8, pa1); PK4(p1, 0, pa2); PK4(p1, 8, pa3);
#undef PK4
}
template <int KB>
__device__ __forceinline__ void qkt(f32x16& p0, f32x16& p1, const char* K_lds, int r32, int hi, const bf16x8* qr, const float* cbt) {
#pragma unroll
    for (int g = 0; g < 4; ++g) { const f32x4 a = *reinterpret_cast<const f32x4*>(cbt + 8 * g), b = *reinterpret_cast<const f32x4*>(cbt + 32 + 8 * g);
        p0[4 * g] = a[0]; p0[4 * g + 1] = a[1]; p0[4 * g + 2] = a[2]; p0[4 * g + 3] = a[3]; p1[4 * g] = b[0]; p1[4 * g + 1] = b[1]; p1[4 * g + 2] = b[2]; p1[4 * g + 3] = b[3]; }
    const char* kb[4];
#pragma unroll
    for (int dd = 0; dd < 4; ++dd) kb[dd] = K_lds + KB * SHM_K + KSWZ(r32, (dd * 16 + hi * 8) * 2);
#pragma unroll
    for (int d0 = 0; d0 < 8; ++d0) { const char* a = kb[d0 & 3] + (d0 >> 2) * 128;
        bf16x8 b0 = *reinterpret_cast<const bf16x8*>(a);
        bf16x8 b1 = *reinterpret_cast<const bf16x8*>(a + 32 * 256);
        p0 = __builtin_amdgcn_mfma_f32_32x32x16_bf16(b0, qr[d0], p0, 0, 0, 0);
        p1 = __builtin_amdgcn_mfma_f32_32x32x16_bf16(b1, qr[d0], p1, 0, 0, 0); }
}
template <int VB>
__device__ __forceinline__ void pv_tile(f32x16* o, int vb0, bf16x8 pa0, bf16x8 pa1, bf16x8 pa2, bf16x8 pa3) {
#define TRRD(dst, off) asm volatile("ds_read_b64_tr_b16 %0, %1 offset:%2" : "=&v"(dst) : "v"(vb0), "i"(off) : "memory")
#define PV_D0(d0) do { s16x4 l0, l1, l2, l3, h0, h1, h2, h3; constexpr int b_ = VB * SHM_V + v_rd_off(d0, 0, 0);   \
        TRRD(l0, b_); TRRD(h0, b_ + 2048); TRRD(l1, b_ + 4096); TRRD(h1, b_ + 6144); TRRD(l2, b_ + 8192); TRRD(h2, b_ + 10240); TRRD(l3, b_ + 12288); TRRD(h3, b_ + 14336); \
        asm volatile("s_waitcnt lgkmcnt(0)" ::: "memory"); SBAR();   \
        o[d0] = __builtin_amdgcn_mfma_f32_32x32x16_bf16(pa0, (bf16x8){l0[0], l0[1], l0[2], l0[3], h0[0], h0[1], h0[2], h0[3]}, o[d0], 0, 0, 0);   \
        o[d0] = __builtin_amdgcn_mfma_f32_32x32x16_bf16(pa1, (bf16x8){l1[0], l1[1], l1[2], l1[3], h1[0], h1[1], h1[2], h1[3]}, o[d0], 0, 0, 0);   \
        o[d0] = __builtin_amdgcn_mfma_f32_32x32x16_bf16(pa2, (bf16x8){l2[0], l2[1], l2[2], l2[3], h2[0], h2[1], h2[2], h2[3]}, o[d0], 0, 0, 0);   \
        o[d0] = __builtin_amdgcn_mfma_f32_32x32x16_bf16(pa3, (bf16x8){l3[0], l3[1], l3[2], l3[3], h3[0], h3[1], h3[2], h3[3]}, o[d0], 0, 0, 0); } while (0)
    PV_D0(0); PV_D0(1); PV_D0(2); PV_D0(3);
#undef PV_D0
#undef TRRD
}

struct BlockRef { const bf16* Q; const bf16* K; const bf16* V; bf16* O; int P0; int jlo; };
struct Seam { bf16x8 qr[8]; bf16x8 st_v0, st_v1, st_k0, st_k1; };
#define ROW(p, k0, rr) ((p) + (size_t)((k0) + (rr)) * D + sc)
#define VMW() asm volatile("s_waitcnt vmcnt(0)" ::: "memory")
#define VMWN(n) asm volatile("s_waitcnt vmcnt(%0)" :: "i"(n) : "memory")
#define SLOAD_H(Kp, Vp, k0) do { S.st_v0 = load8(ROW(Vp, k0, sr)); S.st_v1 = load8(ROW(Vp, k0, 32 + sr));              \
                         S.st_k0 = load8(ROW(Kp, k0, sr)); S.st_k1 = load8(ROW(Kp, k0, 32 + sr)); } while (0)
#define SWRITE_HK(bf) do { *(bf16x8*)(K_lds + (bf) * SHM_K + kws) = S.st_k0; *(bf16x8*)(K_lds + (bf) * SHM_K + kws + 32 * 256) = S.st_k1; } while (0)
#define SWRITE_HV(bf) do { *(bf16x8*)(V_lds + (bf) * SHM_V + vst0) = S.st_v0; *(bf16x8*)(V_lds + (bf) * SHM_V + vst1) = S.st_v1; } while (0)
#define SWRITE_H(bf) do { SWRITE_HV(bf); SWRITE_HK(bf); } while (0)
__device__ __forceinline__ void fox_prime(const BlockRef& cur, char* lds, Seam& S) {
    const int tid = threadIdx.x, wid = __builtin_amdgcn_readfirstlane(tid >> 6), lane = tid & 63, r32 = lane & 31, hi = lane >> 5;
    const int sr = tid >> 4, sc = (tid & 15) * 8, kws = KSWZ(sr, sc * 2); char* K_lds = lds + 2 * SHM_V;
#pragma unroll
    for (int d0 = 0; d0 < 8; ++d0) S.qr[d0] = load8(cur.Q + (size_t)(wid * QBLK + r32) * D + d0 * 16 + hi * 8);
    SLOAD_H(cur.K, cur.V, cur.P0 + QB - KVBLK); VMW(); SWRITE_HK(0);
    __syncthreads();
}
__device__ __forceinline__ void fox_block(const BlockRef& cur, const BlockRef& nxt, char* lds, Seam& S) {
    const int tid = threadIdx.x, wid = __builtin_amdgcn_readfirstlane(tid >> 6), lane = tid & 63, r32 = lane & 31, hi = lane >> 5;
    const int NTK = (cur.P0 + QB - 1) / KVBLK + 1, NT = NTK - cur.jlo;
    const int qlo = cur.P0 + wid * QBLK, qm = qlo + r32 - 4 * hi;
    char* V_lds = lds; char* K_lds = lds + 2 * SHM_V;
    float* ws = (float*)(lds + 2 * SHM_V + 2 * SHM_K) + wid * 64; float* li_l = ws, * al_l = ws + 32;
    int hi_o; asm volatile("v_mov_b32 %0, %1" : "=v"(hi_o) : "v"(hi));
    const float* cbl = (const float*)(lds + CB_OFF) + 4 * hi_o;
    float m_reg = -1e30f, l_reg = 0; f32x16 o[4] = {};
    const int sr = tid >> 4, sc = (tid & 15) * 8, vst0 = v_st(sr, sc), vst1 = v_st(32 + sr, sc), kws = KSWZ(sr, sc * 2);
    const int vb0 = (int)(uintptr_t)V_lds + v_rd_base(lane);
    const bf16* Kh = cur.K; const bf16* Vh = cur.V;
#define RESC(a) do { if (__any((a) < 1.f)) { if (hi == 0) al_l[r32] = (a); asm volatile("s_waitcnt lgkmcnt(0)" ::: "memory");              \
                     for (int d_ = 0; d_ < 4; ++d_) for (int r = 0; r < 16; ++r) o[d_][r] *= al_l[crow(r, hi)]; } } while (0)
#define KBASE(t) ((NTK - 1 - (t)) * KVBLK)
#define MASKT(P0_, P1_, t) do { const int kb_ = KBASE(t); if (kb_ + KVBLK - 1 > qlo) mask_tile(P0_, P1_, qm - kb_); } while (0)
#define SEAM_K0() do { VMWN(8); SWRITE_HK(0); SBAR(); } while (0)
    f32x16 pA0, pA1, pB0, pB1; float mnA, mnB, alA, alB; bf16x8 pa0, pa1, pa2, pa3;
    SWRITE_HV(0); SBAR();
    if (NT > 1) SLOAD_H(Kh, Vh, KBASE(1));
    SBAR(); qkt<0>(pA0, pA1, K_lds, r32, hi, S.qr, cbl + KBASE(0));
    MASKT(pA0, pA1, 0); partialSM(pA0, pA1, m_reg, mnA, alA);
    if (NT > 1) { VMW(); SWRITE_H(1); }
    __syncthreads();
#define HALF_STEP(PX0, PX1, mnX, alX, PY0, PY1, alY, t, KB, VB, SB) do {                                                      \
        SBAR(); qkt<KB>(PX0, PX1, K_lds, r32, hi, S.qr, cbl + KBASE(t));                                                      \
        finishSM(PY0, PY1, alY, l_reg, pa0, pa1, pa2, pa3); SBAR();                                                           \
        if ((t) + 1 < NT) { SLOAD_H(Kh, Vh, KBASE((t) + 1)); SBAR(); }                                                        \
        pv_tile<VB>(o, vb0, pa0, pa1, pa2, pa3); MASKT(PX0, PX1, (t)); partialSM(PX0, PX1, m_reg, mnX, alX);                  \
        __syncthreads();                                                                                                      \
        if ((t) + 1 < NT) { VMW(); SWRITE_H(SB); }                                                                            \
        RESC(alX); __syncthreads(); } while (0)
    for (int t = 1; t + 1 < NT; t += 2) {
        HALF_STEP(pB0, pB1, mnB, alB, pA0, pA1, alA, t, 1, 0, 0);
        HALF_STEP(pA0, pA1, mnA, alA, pB0, pB1, alB, t + 1, 0, 1, 1);
    }
    const bool even = (NT & 1) == 0;
    if (even) { SBAR(); qkt<1>(pB0, pB1, K_lds, r32, hi, S.qr, cbl + KBASE(NT - 1)); SBAR(); }
    SLOAD_H(nxt.K, nxt.V, nxt.P0 + QB - KVBLK); SBAR();
#pragma unroll
    for (int d0 = 0; d0 < 8; ++d0) S.qr[d0] = load8(nxt.Q + (size_t)(wid * QBLK + r32) * D + d0 * 16 + hi * 8);
    SBAR();
    finishSM(pA0, pA1, alA, l_reg, pa0, pa1, pa2, pa3); SBAR();
    pv_tile<0>(o, vb0, pa0, pa1, pa2, pa3);
    if (even) { MASKT(pB0, pB1, NT - 1); partialSM(pB0, pB1, m_reg, mnB, alB); __syncthreads(); RESC(alB);
        finishSM(pB0, pB1, alB, l_reg, pa0, pa1, pa2, pa3); SBAR(); pv_tile<1>(o, vb0, pa0, pa1, pa2, pa3); }
    SBAR(); SEAM_K0();
    if (hi == 0) li_l[r32] = l_reg; asm volatile("s_waitcnt lgkmcnt(0)" ::: "memory");
    float rli[16];
#pragma unroll
    for (int r = 0; r < 16; ++r) rli[r] = __builtin_amdgcn_rcpf(li_l[crow(r, hi)]);
    int anchor; asm volatile("v_mov_b32 %0, 0" : "=v"(anchor));
    char* Ow = (char*)(cur.O + (size_t)(wid * QBLK) * OSTRIDE) + (unsigned)(anchor + ((4 * hi) * OSTRIDE + r32) * 2);
#pragma unroll
    for (int r = 0; r < 16; ++r) { const int orow0 = (r & 3) + 8 * (r >> 2);
#pragma unroll
        for (int d0 = 0; d0 < 4; ++d0) { const float v = o[d0][r] * rli[r];
            const float vn = __shfl_xor(v, 1);
            if ((r32 & 1) == 0) *(unsigned*)(Ow + (orow0 * OSTRIDE + d0 * 32) * 2) = cvtpk(v, vn); } }
    __syncthreads();
#undef RESC
#undef KBASE
#undef MASKT
#undef SEAM_K0
#undef HALF_STEP
}
#undef ROW
#undef VMW
#undef VMWN
#undef SLOAD_H
#undef SWRITE_HK
#undef SWRITE_HV
#undef SWRITE_H
}

constexpr int NWAVES = 8;
constexpr int DM = 4096, DFF = 11008, SEQ = 8192, NMETA = 16, L = SEQ + NMETA  , LP = 8448  ;
constexpr int FOXH = 16, FOXD = 128, FOXW = 2048;
constexpr int GLAH = 4, GDK = 256, GDV = 512, GKW = 1024, GVW = 2048, GRANK = 16, NCHUNK = 129, CHUNK = 64, PADL = 48;
constexpr int DIN = 12320;
constexpr float EPS = 1e-6f;
constexpr int WIN_ROWS = 49 * 256 + 32 * 256;
constexpr int WIN_SMALL = 12288, WIN_GATE = 12544;

constexpr size_t MiB = 1u << 20;
constexpr size_t WS_CTL = 0, CTL_ZERO_BYTES = 1 * MiB;
constexpr size_t WS_W1A = 1 * MiB, WS_W1B = 173 * MiB, WS_WIN = 259 * MiB, WS_WP = 421 * MiB, WS_WO = 453 * MiB, WS_W2A = 485 * MiB, WS_W2B = 657 * MiB;
constexpr size_t WS_ABUF = 743 * MiB, WS_HID = 809 * MiB, WS_H = 987 * MiB, WS_GA = 1119 * MiB, WS_GB = 1185 * MiB, WS_OAB = 1251 * MiB;
constexpr size_t WS_KDT = 1317 * MiB, WS_VT = 1334 * MiB, WS_GG = 1367 * MiB, WS_SM = 1368 * MiB  , WS_CB = 1370 * MiB, WS_END = 1371 * MiB;
constexpr size_t WS_FQ = 1 * MiB, WS_FK = 34 * MiB, WS_FV = 67 * MiB, WS_GQ = 100 * MiB, WS_GK = 117 * MiB, WS_GV = 134 * MiB, WS_GR = 167 * MiB;
constexpr size_t WS_A8 = 1053 * MiB  , WS_WG8 = WS_WIN + (size_t)WIN_GATE * DM * 2  ;
constexpr size_t WS_OPART = WS_HID  , WS_Y = WS_HID, WS_YBF = 1 * MiB;
static_assert((size_t)WIN_ROWS * DM * 2 == 162 * MiB && (size_t)22016 * DM * 2 == 172 * MiB && (size_t)LP * DM * 2 == 66 * MiB && (size_t)LP * DFF * 2 <= 178 * MiB && (size_t)LP * DM * 4 == 132 * MiB, "ws map");
static_assert((size_t)FOXH * LP * FOXD * 2 == 33 * MiB && (size_t)LP * GKW * 2 <= 17 * MiB && (size_t)LP * GVW * 2 == 33 * MiB && (size_t)GLAH * NCHUNK * GDK * CHUNK * 2 <= 17 * MiB && (size_t)GLAH * NCHUNK * GDV * CHUNK * 2 <= 33 * MiB, "ws map 2");
constexpr int CW_TMO = 0, CW_CODE = 1, CW_BAR = 4096, CW_QUEUE = 8192, CW_PANEL = 10240  , CW_PANEL9 = 10752  , CW_QKN = 12288  , CW_SS2 = 16384, CW_SS3 = 16384 + 2 * 8704, CW_SS4 = 16384 + 4 * 8704;
constexpr int WCH_G = 0, WCH_F2 = 8192, WCH_F1 = 8192 + 22016, WCH_N = WCH_F1 + 22016;
constexpr int CW_WMAX = CW_SS4 + 2 * 8704  , CW_AMAX3 = CW_WMAX + WCH_N  ,
    CW_WSS = CW_AMAX3 + 8704  ;
constexpr size_t WS_WCLIP = 1087 * MiB;
constexpr size_t WS_RS1 = 1088 * MiB, WS_RS2 = WS_RS1 + LP * 4, WS_RS3 = WS_RS2 + LP * 4;
static_assert(CW_SS4 + 2 * 8704 <= CW_WMAX && (CW_WSS & 1) == 0 && (CW_WSS + 2 * WCH_N) * 4 <= (int)CTL_ZERO_BYTES, "CTL map");
static_assert((CW_SS4 + 2 * 8704) * 4 <= (int)CTL_ZERO_BYTES, "CTL words inside the memset region");

constexpr int RING_OFF = 0, RING_BYTES = 131072;
constexpr int LDSCTL_OFF = RING_BYTES, MISC_OFF = LDSCTL_OFF + 320;
constexpr int LDS_BYTES = 147456;
static_assert(MISC_OFF + 128 <= LDS_BYTES && fox::CB_OFF + LP * 4 <= RING_BYTES, "LDS map");

#define GAS __attribute__((address_space(1)))
#define LAS __attribute__((address_space(3)))
typedef unsigned short bf16;
typedef unsigned v4u __attribute__((ext_vector_type(4)));
typedef unsigned v2u __attribute__((ext_vector_type(2)));
typedef float f32x4 __attribute__((ext_vector_type(4)));
typedef float f32x2 __attribute__((ext_vector_type(2)));
typedef float f32x16 __attribute__((ext_vector_type(16)));
typedef short bf16x8 __attribute__((ext_vector_type(8)));
typedef short bf16x4 __attribute__((ext_vector_type(4)));
typedef GAS unsigned gu32;
typedef unsigned long long ssq_t;
constexpr float SSFIX = 4294967296.0f;
#define RLX_AGENT __ATOMIC_RELAXED, __HIP_MEMORY_SCOPE_AGENT
#define LDS_WAIT() asm volatile("s_waitcnt lgkmcnt(0)" ::: "memory")
#define VM_WAIT() asm volatile("s_waitcnt vmcnt(0)" ::: "memory")
typedef __bf16 bf16x2_t __attribute__((ext_vector_type(2)));
__device__ __forceinline__ unsigned pk2(float lo, float hi) { f32x2 v = {lo, hi}; bf16x2_t b = __builtin_convertvector(v, bf16x2_t); return __builtin_bit_cast(unsigned, b); }
__device__ __forceinline__ float bf_lo(unsigned w) { return __uint_as_float(w << 16); }
__device__ __forceinline__ float bf_hi(unsigned w) { return __uint_as_float(w & 0xffff0000u); }
__device__ __forceinline__ float sigmoidf_fast(float x) { return __builtin_amdgcn_rcpf(1.0f + __builtin_amdgcn_exp2f(-1.4426950408889634f * x)); }
__device__ __forceinline__ float siluf_fast(float x) { return x * sigmoidf_fast(x); }
__device__ __forceinline__ float log_sigmoidf_acc(float z) { return fminf(z, 0.f) - log1pf(expf(-fabsf(z))); }
__device__ __forceinline__ float log_sigmoidf_fast(float z) { const float t = __builtin_amdgcn_exp2f(-1.4426950408889634f * fabsf(z)); return fminf(z, 0.f) - 0.6931471805599453f * __builtin_amdgcn_logf(1.0f + t); }
__device__ __forceinline__ float expf_fast(float x) { return __builtin_amdgcn_exp2f(1.4426950408889634f * x); }
__device__ __forceinline__ int lane_id_fresh() { int l; asm volatile("v_mbcnt_lo_u32_b32 %0, -1, 0\n\tv_mbcnt_hi_u32_b32 %0, -1, %0" : "=v"(l)); return l; }
__device__ __forceinline__ float wave_sum(float v) {
#pragma unroll
    for (int o = 1; o < 64; o <<= 1) v += __shfl_xor(v, o);
    return v;
}

#define XB_TMO      128
#define XB_XCNT(j)  (256  + 64 * (j))
#define XB_XSUB(j)  (1280 + 64 * (j))
#define XB_XGEN(j)  (2304 + 64 * (j))
#define XB_TOP      3328
#define XB_TOPGEN   3392
#define XCD_BAR_WORDS 3456
#define XB_SPIN_CAP (1u << 18)
__device__ __forceinline__ unsigned xb_ld(unsigned* p)              { return __hip_atomic_load(p, __ATOMIC_RELAXED, __HIP_MEMORY_SCOPE_AGENT); }
__device__ __forceinline__ unsigned xb_add(unsigned* p, unsigned v) { return __hip_atomic_fetch_add(p, v, __ATOMIC_RELAXED, __HIP_MEMORY_SCOPE_AGENT); }
__device__ __forceinline__ unsigned xb_xcc_id() { return (unsigned)__builtin_amdgcn_s_getreg((3 << 11) | 20) & 0xFu; }
#define XB_SPIN(cond, bar) do { unsigned _sp = 0; while (cond) { __builtin_amdgcn_s_sleep(1); \
    if ((++_sp & 255u) == 0u) { if (xb_ld(&(bar)[XB_TMO])) break; if (_sp > XB_SPIN_CAP) { atomicAdd(&(bar)[XB_TMO], 1u); break; } } } } while (0)
struct XcdBarrier { unsigned* bar; unsigned x; volatile LAS unsigned* st; };
__device__ __forceinline__ XcdBarrier xcd_barrier_post(unsigned* bar, volatile LAS unsigned* st) {
    XcdBarrier b; b.bar = bar; b.x = xb_xcc_id(); b.st = st;
    if (threadIdx.x == 0) (void)xb_add(&bar[XB_XCNT(b.x)], 1u);
    return b;
}
__device__ __forceinline__ void xcd_barrier_complete(unsigned* bar, unsigned x, unsigned& nloc, unsigned& nx) {
    const unsigned G = gridDim.x * gridDim.y * gridDim.z;
    unsigned sum, cnt, mine, sp = 0u;
    for (;;) {
        sum = 0u; cnt = 0u; mine = 0u;
#pragma unroll
        for (unsigned j = 0; j < 16; ++j) { const unsigned c = xb_ld(&bar[XB_XCNT(j)]); sum += c; cnt += (c > 0u) ? 1u : 0u; mine = (j == x) ? c : mine; }
        if (sum == G) break;
        __builtin_amdgcn_s_sleep(1);
        if ((++sp & 255u) == 0u) { if (xb_ld(&bar[XB_TMO])) break; if (sp > XB_SPIN_CAP) { atomicAdd(&bar[XB_TMO], 1u); break; } }
    }
    nloc = mine > 0u ? mine : 1u; nx = cnt > 0u ? cnt : 1u;
}
__device__ __forceinline__ void xcd_barrier(const XcdBarrier& b) {
    asm volatile("s_waitcnt vmcnt(0)" ::: "memory");
    __syncthreads();
    if (threadIdx.x == 0) {
        unsigned* bar = b.bar;
        __builtin_amdgcn_s_waitcnt(0);
        unsigned nloc = b.st[0], nx = b.st[1];
        if (nloc == 0u) { xcd_barrier_complete(bar, b.x, nloc, nx); b.st[0] = nloc; b.st[1] = nx; }
        const unsigned old = xb_add(&bar[XB_XSUB(b.x)], 1u);
        const unsigned gen = old / nloc;
        if (old + 1u == (gen + 1u) * nloc) {
            __builtin_amdgcn_fence(__ATOMIC_RELEASE, "agent");
            asm volatile("s_waitcnt vmcnt(0)" ::: "memory");
            const unsigned og = xb_add(&bar[XB_TOP], 1u);
            const unsigned tg = og / nx;
            if (og + 1u == (tg + 1u) * nx) xb_add(&bar[XB_TOPGEN], 1u);
            else XB_SPIN(xb_ld(&bar[XB_TOPGEN]) == tg, bar);
            __builtin_amdgcn_fence(__ATOMIC_ACQUIRE, "agent");
            xb_add(&bar[XB_XGEN(b.x)], 1u);
            asm volatile("s_waitcnt vmcnt(0)" ::: "memory");
        } else {
            XB_SPIN(xb_ld(&bar[XB_XGEN(b.x)]) == gen, bar);
            __builtin_amdgcn_fence(__ATOMIC_ACQUIRE, "agent");
            asm volatile("s_waitcnt vmcnt(0)" ::: "memory");
        }
    }
    __syncthreads();
}

struct Args { const float* in[21]; float* out; unsigned char* ws; int ph_lo, ph_hi; };
static_assert(sizeof(Args) == 24 * 8, "Args has no holes");
struct Frame {
    LAS unsigned char* lds;
    unsigned char* ldsg;
    volatile LAS unsigned* MISC;
    unsigned* ctl;
    int tid, lane, wave, G;
    unsigned char* ws;
};
enum { I_X = 0, I_META, I_N1G, I_F1W1, I_F1W3, I_F1W2, I_NMIXG, I_WIN, I_FBIAS, I_AW2, I_AB, I_GNG, I_WGATE, I_WPF, I_WPG, I_WOUT, I_N2G, I_F2W1, I_F2W3, I_F2W2, I_NFG };

struct CvtRegs { f32x4 v[8][2]; };
__device__ __forceinline__ void cvt_load(CvtRegs& R, const float* src, int ldsrc, int srccol0, int k0, int n0, int lane) {
    const int g = lane >> 4, c = lane & 15;
#pragma unroll
    for (int j = 0; j < 8; ++j)
#pragma unroll
        for (int e = 0; e < 2; ++e) R.v[j][e] = *(const f32x4*)(src + (size_t)(k0 + 8 * j + 2 * g + e) * ldsrc + srccol0 + n0 + 4 * c);
}
template <bool ILV>
__device__ __forceinline__ void cvt_store(const CvtRegs& R, int k0, int n0, bf16* dst, int lddst, int dstcol0, int dstrow0, LAS unsigned* T, int lane) {
    const int g = lane >> 4, c = lane & 15;
#pragma unroll
    for (int j = 0; j < 8; ++j)
#pragma unroll
        for (int i = 0; i < 4; ++i) T[(4 * c + i) * 33 + 4 * j + g] = pk2(R.v[j][0][i], R.v[j][1][i]);
    LDS_WAIT(); asm volatile("" ::: "memory");
    const int cc = lane & 7;
#pragma unroll
    for (int q = 0; q < 8; ++q) { const int n = 8 * q + (lane >> 3); const LAS unsigned* s = T + n * 33 + 4 * cc;
        v4u o; o.x = s[0]; o.y = s[1]; o.z = s[2]; o.w = s[3];
        const int nn = n0 + n, drow = dstrow0 + (ILV ? 256 * (nn >> 7) + (nn & 127) : nn);
        *(v4u*)(dst + (size_t)drow * lddst + dstcol0 + k0 + 8 * cc) = o; }
    LDS_WAIT(); asm volatile("" ::: "memory");
}
template <bool ILV>
__device__ __forceinline__ void cvt_matrix(Frame& F, const float* src, int ldsrc, int srccol0, int ncols, int K, bf16* dst, int lddst, int dstcol0, int dstrow0, int rot) {
    LAS unsigned* T = (LAS unsigned*)(F.lds + RING_OFF + F.wave * 8448);
    const int NGW = F.G * NWAVES; const int gw = ((int)blockIdx.x * NWAVES + F.wave + rot) % NGW;
    const int nnb = ncols / 64, ntiles = (K / 64) * nnb;
    CvtRegs Ra, Rb;
#define CVT_IT(j) ((((j) >> 1) * NGW + gw) * 2 + ((j) & 1))
    int j = 0;
    if (CVT_IT(0) < ntiles) cvt_load(Ra, src, ldsrc, srccol0, (CVT_IT(0) / nnb) * 64, (CVT_IT(0) % nnb) * 64, F.lane);
    for (;;) { const int i0 = CVT_IT(j), i1 = CVT_IT(j + 1), i2 = CVT_IT(j + 2);
        if (i0 >= ntiles) break;
        if (i1 < ntiles) cvt_load(Rb, src, ldsrc, srccol0, (i1 / nnb) * 64, (i1 % nnb) * 64, F.lane);
        cvt_store<ILV>(Ra, (i0 / nnb) * 64, (i0 % nnb) * 64, dst, lddst, dstcol0, dstrow0, T, F.lane);
        if (i1 >= ntiles) break;
        if (i2 < ntiles) cvt_load(Ra, src, ldsrc, srccol0, (i2 / nnb) * 64, (i2 % nnb) * 64, F.lane);
        cvt_store<ILV>(Rb, (i1 / nnb) * 64, (i1 % nnb) * 64, dst, lddst, dstcol0, dstrow0, T, F.lane);
        j += 2; }
#undef CVT_IT
}
constexpr int WSAMP = 16; constexpr float WCSIG = 3.9f, WSS_FIX = 1099511627776.0f  ;
__device__ __forceinline__ void wmax_fold(const CvtRegs& R, f32x4& mx, f32x4& sq) {
#pragma unroll
    for (int j = 0; j < 8; ++j)
#pragma unroll
        for (int e = 0; e < 2; ++e)
#pragma unroll
            for (int i = 0; i < 4; ++i) { mx[i] = fmaxf(mx[i], fabsf(R.v[j][e][i])); sq[i] += R.v[j][e][i] * R.v[j][e][i]; }
}
template <bool ILV>
__device__ __forceinline__ void wmax_matrix(Frame& F, const float* src, int ldsrc, int srccol0, int ncols, int K, int ch0, int rot) {
    unsigned* wmax = F.ctl + CW_WMAX + ch0; unsigned long long* wss = (unsigned long long*)(F.ctl + CW_WSS) + ch0;
    const int NGW = F.G * NWAVES; const int gw = ((int)blockIdx.x * NWAVES + F.wave + rot) % NGW;
    const int nnb = ncols / 64, nitems = nnb * (K / (128 * WSAMP));
    for (int it = gw; it < nitems; it += NGW) { const int n0 = (it % nnb) * 64, kb = (it / nnb) * (128 * WSAMP);
        CvtRegs Ra, Rb; f32x4 mx = {0.f, 0.f, 0.f, 0.f}, sq = {0.f, 0.f, 0.f, 0.f};
        cvt_load(Ra, src, ldsrc, srccol0, kb, n0, F.lane); cvt_load(Rb, src, ldsrc, srccol0, kb + 64, n0, F.lane);
        wmax_fold(Ra, mx, sq); wmax_fold(Rb, mx, sq);
#pragma unroll
        for (int i = 0; i < 4; ++i) { float m = mx[i], q = sq[i]; m = fmaxf(m, __shfl_xor(m, 16)); m = fmaxf(m, __shfl_xor(m, 32)); q += __shfl_xor(q, 16); q += __shfl_xor(q, 32);
            if (F.lane < 16) { const int nn = n0 + 4 * F.lane + i, ch = ILV ? 256 * (nn >> 7) + (nn & 127) : nn; atomicMax(wmax + ch, __float_as_uint(m)); atomicAdd(wss + ch, (unsigned long long)(q * WSS_FIX)); } } }
}
__device__ __forceinline__ void cvt8_load(CvtRegs& R, const float* src, int ldsrc, int srccol0, int k0, int n0, int lane) {
    const int g = lane >> 4, c = lane & 15;
#pragma unroll
    for (int j2 = 0; j2 < 4; ++j2)
#pragma unroll
        for (int e = 0; e < 4; ++e) R.v[2 * j2 + (e >> 1)][e & 1] = *(const f32x4*)(src + (size_t)(k0 + 16 * j2 + 4 * g + e) * ldsrc + srccol0 + n0 + 4 * c);
}
#define SAT127(x) __builtin_amdgcn_fmed3f((x), -127.0f, 127.0f)
__device__ __forceinline__ unsigned pack4_i8(float a, float b, float c, float d) {
    const int qa = (int)rintf(a), qb = (int)rintf(b), qc = (int)rintf(c), qd = (int)rintf(d);
    return (unsigned)(qa & 255) | ((unsigned)(qb & 255) << 8) | ((unsigned)(qc & 255) << 16) | ((unsigned)qd << 24);
}
template <bool ILV>
__device__ __forceinline__ void cvt8_store(const CvtRegs& R, int k0, int n0, unsigned char* dst, int lddst, int dstrow0, const unsigned* wmax, const unsigned long long* wss, float* wclip, float inv_ns, LAS unsigned* T, int lane) {
    const int g = lane >> 4, c = lane & 15;
    float sc[4];
#pragma unroll
    for (int i = 0; i < 4; ++i) { const int nn = n0 + 4 * c + i, ch = ILV ? 256 * (nn >> 7) + (nn & 127) : nn; const float m = fmaxf(__uint_as_float(wmax[ch]), WCSIG * sqrtf((float)wss[ch] * (inv_ns / WSS_FIX))); sc[i] = m > 0.f ? 127.0f / m : 0.f;
        if (k0 == 0 && g == 0) wclip[ch] = m; }
#pragma unroll
    for (int j2 = 0; j2 < 4; ++j2)
#pragma unroll
        for (int i = 0; i < 4; ++i) T[(4 * c + i) * 17 + 4 * j2 + g] = pack4_i8(SAT127(R.v[2 * j2][0][i] * sc[i]), SAT127(R.v[2 * j2][1][i] * sc[i]), SAT127(R.v[2 * j2 + 1][0][i] * sc[i]), SAT127(R.v[2 * j2 + 1][1][i] * sc[i]));
    LDS_WAIT(); asm volatile("" ::: "memory");
    const int cc = lane & 3;
#pragma unroll
    for (int q = 0; q < 4; ++q) { const int n = 16 * q + (lane >> 2); const LAS unsigned* t = T + n * 17 + 4 * cc;
        v4u o; o.x = t[0]; o.y = t[1]; o.z = t[2]; o.w = t[3];
        const int nn = n0 + n, drow = dstrow0 + (ILV ? 256 * (nn >> 7) + (nn & 127) : nn);
        *(v4u*)(dst + (size_t)drow * lddst + k0 + 16 * cc) = o; }
    LDS_WAIT(); asm volatile("" ::: "memory");
}
template <bool ILV>
__device__ __forceinline__ void cvt8_matrix(Frame& F, const float* src, int ldsrc, int srccol0, int ncols, int K, unsigned char* dst, int lddst, int dstrow0, int ch0, int rot, int wg, int nwg, int wv, int nwv, int tbase, int e_lo = 0, int e_hi = 8) {
    const unsigned* wmax = F.ctl + CW_WMAX + ch0; const unsigned long long* wss = (const unsigned long long*)(F.ctl + CW_WSS) + ch0; float* wclip = (float*)(F.ws + WS_WCLIP) + ch0; const float inv_ns = (float)WSAMP / (float)K;
    LAS unsigned* T = (LAS unsigned*)(F.lds + tbase + wv * 8448);
    const int NGW = nwg * nwv; const int gw = (wg * nwv + wv + rot) % NGW;
    const int nnb = ncols / 64, npairs = (K / 64) * nnb / 2, pair_lo = (int)((long)npairs * e_lo / 8), ntiles = 2 * (int)((long)npairs * e_hi / 8);
    CvtRegs Ra, Rb;
#define CVT_IT(j) ((pair_lo + ((j) >> 1) * NGW + gw) * 2 + ((j) & 1))
    int j = 0;
    if (CVT_IT(0) < ntiles) cvt8_load(Ra, src, ldsrc, srccol0, (CVT_IT(0) / nnb) * 64, (CVT_IT(0) % nnb) * 64, F.lane);
    for (;;) { const int i0 = CVT_IT(j), i1 = CVT_IT(j + 1), i2 = CVT_IT(j + 2);
        if (i0 >= ntiles) break;
        if (i1 < ntiles) cvt8_load(Rb, src, ldsrc, srccol0, (i1 / nnb) * 64, (i1 % nnb) * 64, F.lane);
        cvt8_store<ILV>(Ra, (i0 / nnb) * 64, (i0 % nnb) * 64, dst, lddst, dstrow0, wmax, wss, wclip, inv_ns, T, F.lane);
        if (i1 >= ntiles) break;
        if (i2 < ntiles) cvt8_load(Ra, src, ldsrc, srccol0, (i2 / nnb) * 64, (i2 % nnb) * 64, F.lane);
        cvt8_store<ILV>(Rb, (i1 / nnb) * 64, (i1 % nnb) * 64, dst, lddst, dstrow0, wmax, wss, wclip, inv_ns, T, F.lane);
        j += 2; }
#undef CVT_IT
}
__device__ __forceinline__ void n1_row(Frame& F, const Args& A, int pos, unsigned char* orow, float* rs) {
    GAS unsigned* o4 = (GAS unsigned*)orow + F.lane;
    if (pos >= L) {
#pragma unroll
        for (int j = 0; j < 16; ++j) o4[64 * j] = 0u;
        if (F.lane == 0) rs[pos] = 0.f;
        return; }
    const float* xrow = pos < NMETA ? A.in[I_META] + (size_t)pos * DM : A.in[I_X] + (size_t)(pos - NMETA) * DM;
    const f32x4* xr = (const f32x4*)xrow + F.lane; const f32x4* gr = (const f32x4*)A.in[I_N1G] + F.lane;
    f32x4 v[16]; float s = 0.f;
#pragma unroll
    for (int j = 0; j < 16; ++j) { v[j] = xr[64 * j]; s += (v[j].x * v[j].x + v[j].y * v[j].y) + (v[j].z * v[j].z + v[j].w * v[j].w); }
    const float rstd = 1.0f / sqrtf(wave_sum(s) * (1.f / DM) + EPS);
    float am = 0.f;
#pragma unroll
    for (int j = 0; j < 16; ++j) { v[j] = v[j] * rstd * gr[64 * j]; am = fmaxf(am, fmaxf(fmaxf(fabsf(v[j].x), fabsf(v[j].y)), fmaxf(fabsf(v[j].z), fabsf(v[j].w)))); }
#pragma unroll
    for (int o = 1; o < 64; o <<= 1) am = fmaxf(am, __shfl_xor(am, o));
    const float sc = am > 0.f ? 127.0f / am : 0.f;
#pragma unroll
    for (int j = 0; j < 16; ++j) o4[64 * j] = pack4_i8(v[j].x * sc, v[j].y * sc, v[j].z * sc, v[j].w * sc);
    if (F.lane == 0) rs[pos] = am * (1.0f / 127.0f);
}
__device__ __forceinline__ void quantise_ffn1(Frame& F, const Args& A) {
    cvt8_matrix<true >(F, A.in[I_F1W3], DFF, 0, DFF, DM, F.ws + WS_W1A, DM, 128, WCH_F1 + 128, 517, (int)blockIdx.x, F.G, F.wave, NWAVES, RING_OFF);
    cvt8_matrix<true >(F, A.in[I_F1W1], DFF, 0, DFF, DM, F.ws + WS_W1A, DM, 0, WCH_F1, 0, (int)blockIdx.x, F.G, F.wave, NWAVES, RING_OFF);
    __syncthreads();
}
__device__ __forceinline__ void quantise_late(Frame& F, const Args& A, int wg, int nwg, int wv, int nwv, int tbase, int e_lo, int e_hi) {
    unsigned char* WG8 = F.ws + WS_WG8;
    cvt8_matrix<true >(F, A.in[I_WGATE], 2 * DM, DM, DM, DM, WG8, DM, 128, WCH_G + 128, 1301, wg, nwg, wv, nwv, tbase, e_lo, e_hi);
    cvt8_matrix<true >(F, A.in[I_WGATE], 2 * DM, 0, DM, DM, WG8, DM, 0, WCH_G, 89, wg, nwg, wv, nwv, tbase, e_lo, e_hi);
    cvt8_matrix<true >(F, A.in[I_F2W3], DFF, 0, DFF, DM, F.ws + WS_W2A, DM, 128, WCH_F2 + 128, 1700, wg, nwg, wv, nwv, tbase, e_lo, e_hi);
    cvt8_matrix<true >(F, A.in[I_F2W1], DFF, 0, DFF, DM, F.ws + WS_W2A, DM, 0, WCH_F2, 1111, wg, nwg, wv, nwv, tbase, e_lo, e_hi);
}
__device__ __forceinline__ void p0_prologue(Frame& F, const Args& A) {
    unsigned char* ws = F.ws;
    bf16* W1A = (bf16*)(ws + WS_W1A); bf16* W1B = (bf16*)(ws + WS_W1B); bf16* WINb = (bf16*)(ws + WS_WIN); bf16* WP = (bf16*)(ws + WS_WP); bf16* WO = (bf16*)(ws + WS_WO);
    bf16* W2A = (bf16*)(ws + WS_W2A); bf16* W2B = (bf16*)(ws + WS_W2B);
    cvt_matrix<false>(F, A.in[I_F1W2], DM, 0, DM, DFF, W1B, DFF, 0, 0, 1031);
    cvt_matrix<false>(F, A.in[I_WIN], DIN, 0, 6144, DM, WINb, DM, 0, 0, 211);
    cvt_matrix<false>(F, A.in[I_WIN], DIN, 6160, 6144, DM, WINb, DM, 0, 6144, 1543);
    cvt_matrix<false>(F, A.in[I_WPF], DM, 0, DM, FOXW, WP, DM, 0, 0, 700);
    cvt_matrix<false>(F, A.in[I_WPG], DM, 0, DM, GVW, WP, DM, FOXW, 0, 1900);
    cvt_matrix<false>(F, A.in[I_WOUT], DM, 0, DM, DM, WO, DM, 0, 0, 333);
    cvt_matrix<false>(F, A.in[I_F2W2], DM, 0, DM, DFF, W2B, DFF, 0, 0, 59);
    { const size_t gt = (size_t)blockIdx.x * 512 + F.tid, NT = (size_t)F.G * 512;
      for (size_t i = gt; i < (size_t)256 * DM; i += NT) { const int r = (int)(i / DM), k = (int)(i % DM); float v = 0.f;
          if (r < 16) v = A.in[I_WIN][(size_t)k * DIN + 6144 + r]; else if (r < 32) v = A.in[I_WIN][(size_t)k * DIN + 12304 + (r - 16)];
          WINb[(size_t)(WIN_SMALL + r) * DM + k] = (bf16)(pk2(v, 0.f) & 0xffffu); } }
    wmax_matrix<true >(F, A.in[I_F2W1], DFF, 0, DFF, DM, WCH_F2, 1111);
    wmax_matrix<true >(F, A.in[I_F1W1], DFF, 0, DFF, DM, WCH_F1, 0);
    wmax_matrix<true >(F, A.in[I_F1W3], DFF, 0, DFF, DM, WCH_F1 + 128, 517);
    wmax_matrix<true >(F, A.in[I_F2W3], DFF, 0, DFF, DM, WCH_F2 + 128, 1700);
    wmax_matrix<true >(F, A.in[I_WGATE], 2 * DM, 0, DM, DM, WCH_G, 89);
    wmax_matrix<true >(F, A.in[I_WGATE], 2 * DM, DM, DM, DM, WCH_G + 128, 1301);
    { unsigned char* A8_ = ws + WS_A8; const int gw = (int)blockIdx.x * NWAVES + F.wave, NGW = F.G * NWAVES;
      for (int m = gw; m < LP; m += NGW) n1_row(F, A, m, A8_ + (size_t)m * DM, (float*)(ws + WS_RS1)); }
}

typedef pg8::f32x4 A4;
__device__ __forceinline__ void ss_add(ssq_t* p, float sq) { atomicAdd(p, (unsigned long long)(sq * SSFIX)); }
__device__ __forceinline__ float rstd_of(const ssq_t* ss, int row) { return __builtin_amdgcn_rsqf((float)ss[row] * (1.f / (DM * SSFIX)) + EPS); }

__device__ __forceinline__ void rstd8(const ssq_t* ss, int row0, float (&s)[8]) {
    ssq_t t[8];
#pragma unroll
    for (int i = 0; i < 8; ++i) t[i] = ss[row0 + (i >> 2) * 128 + (i & 3) * 16];
#pragma unroll
    for (int i = 0; i < 8; ++i) s[i] = __builtin_amdgcn_rsqf((float)t[i] * (1.f / (DM * SSFIX)) + EPS);
}

struct EpiSwiGLU {
    bf16* O; const ssq_t* ss;
    __device__ __forceinline__ void operator()(const A4 (&acc)[2][2][4][2], const pg8::Unit& u, int wr, int wc, int fr, int fq) const {
        const int row0 = u.arow + wr * 64 + fr, col0 = u.pn * 128 + wc * 32 + 8 * fq;
        float sv[8] = {1.f, 1.f, 1.f, 1.f, 1.f, 1.f, 1.f, 1.f}; if (ss) rstd8(ss, row0, sv);
#pragma unroll
        for (int ai = 0; ai < 2; ++ai)
#pragma unroll
            for (int m = 0; m < 4; ++m) { const int row = row0 + ai * 128 + m * 16; const float s = sv[ai * 4 + m];
                const A4 a0 = acc[ai][0][m][0] * s, a1 = acc[ai][0][m][1] * s, b0 = acc[ai][1][m][0] * s, b1 = acc[ai][1][m][1] * s;
                v4u w; w.x = pk2(siluf_fast(a0[0]) * b0[0], siluf_fast(a0[1]) * b0[1]); w.y = pk2(siluf_fast(a0[2]) * b0[2], siluf_fast(a0[3]) * b0[3]);
                w.z = pk2(siluf_fast(a1[0]) * b1[0], siluf_fast(a1[1]) * b1[1]); w.w = pk2(siluf_fast(a1[2]) * b1[2], siluf_fast(a1[3]) * b1[3]);
                *(v4u*)(O + (size_t)row * DFF + col0) = w; }
    }
};
template <int MODE> struct EpiResid {
    const float* x; const float* meta; const bf16* H; float* dout; bf16* anext; const float* gnext; ssq_t* ss; float alpha; bf16* Hout;
    __device__ __forceinline__ void operator()(const A4 (&acc)[2][2][4][2], const pg8::Unit& u, int wr, int wc, int fr, int fq) const {
        const int row0 = u.arow + wr * 64 + fr, col0 = u.pn * 256 + wc * 32 + 8 * fq;
        A4 gv[2][2];
        if (MODE != 2) {
#pragma unroll
            for (int bj = 0; bj < 2; ++bj)
#pragma unroll
                for (int n = 0; n < 2; ++n) gv[bj][n] = *(const A4*)(gnext + col0 + bj * 128 + 4 * n); }
        A4 hv[2][4];
#define RES_LOAD(slot, gi) do { const int row_ = row0 + ((gi) >> 2) * 128 + ((gi) & 3) * 16; \
            if (MODE == 0) { const float* hp_; bool z_ = false; if (row_ < NMETA) hp_ = meta + (size_t)row_ * DM; else if (row_ < L) hp_ = x + (size_t)(row_ - NMETA) * DM; else { hp_ = x; z_ = true; } \
                _Pragma("unroll") for (int q_ = 0; q_ < 4; ++q_) { hv[slot][q_] = *(const A4*)(hp_ + col0 + (q_ >> 1) * 128 + 4 * (q_ & 1)); if (z_) hv[slot][q_] = (A4){0.f, 0.f, 0.f, 0.f}; } } \
            else { _Pragma("unroll") for (int b_ = 0; b_ < 2; ++b_) { const v4u w_ = *(const v4u*)(H + (size_t)row_ * DM + col0 + b_ * 128); \
                hv[slot][2 * b_] = (A4){bf_lo(w_.x), bf_hi(w_.x), bf_lo(w_.y), bf_hi(w_.y)}; hv[slot][2 * b_ + 1] = (A4){bf_lo(w_.z), bf_hi(w_.z), bf_lo(w_.w), bf_hi(w_.w)}; } } } while (0)
        RES_LOAD(0, 0);
#pragma unroll
        for (int gi = 0; gi < 8; ++gi) { const int ai = gi >> 2, m = gi & 3, row = row0 + ai * 128 + m * 16, sl = gi & 1;
            if (gi + 1 < 8) RES_LOAD((gi + 1) & 1, gi + 1);
            float sq = 0.f;
#pragma unroll
            for (int bj = 0; bj < 2; ++bj) { A4 v[2];
#pragma unroll
                for (int n = 0; n < 2; ++n) { v[n] = hv[sl][bj * 2 + n] + acc[ai][bj][m][n] * alpha; sq += (v[n][0] * v[n][0] + v[n][1] * v[n][1]) + (v[n][2] * v[n][2] + v[n][3] * v[n][3]);
                    }
                { v4u hw; hw.x = pk2(v[0][0], v[0][1]); hw.y = pk2(v[0][2], v[0][3]); hw.z = pk2(v[1][0], v[1][1]); hw.w = pk2(v[1][2], v[1][3]);
                    *(v4u*)(Hout + (size_t)row * DM + col0 + bj * 128) = hw; }
                if (MODE != 2) { const A4 p = v[0] * gv[bj][0], q = v[1] * gv[bj][1]; v4u w; w.x = pk2(p[0], p[1]); w.y = pk2(p[2], p[3]); w.z = pk2(q[0], q[1]); w.w = pk2(q[2], q[3]);
                    *(v4u*)(anext + (size_t)row * DM + col0 + bj * 128) = w; } }
            sq += __shfl_xor(sq, 16); sq += __shfl_xor(sq, 32);
            if (fq == 0) ss_add(ss + row, sq); }
#undef RES_LOAD
    }
};
struct PanelOrder { int G, c;
    __device__ bool next(int i, pg8::Unit& u) const { const int Lu = i * G + c; if (Lu >= 512) return false; int pm, pn;
        if (G == 256) { const int x = c & 7, k = c >> 3; pm = 16 * i + 8 * (x >> 2) + (k & 7); pn = 4 * (x & 3) + (k >> 3); }
        else { pm = Lu >> 4; pn = Lu & 15; }
        u.arow = NMETA + pm * 256; u.brow = pn * 256; u.pn = pn; return true; } };
struct EpiFinal {
    const bf16* H; float* out; const float* gfin; ssq_t* ss; unsigned* cnt; unsigned* bar; float alpha;
    __device__ __forceinline__ void operator()(A4 (&acc)[2][2][4][2], const pg8::Unit& u, int wr, int wc, int fr, int fq) const {
        const int row0 = u.arow + wr * 64 + fr, col0 = u.pn * 256 + wc * 32 + 8 * fq;
        A4 hv[2][4];
#define FIN_LOAD(slot, gi) do { const int row_ = row0 + ((gi) >> 2) * 128 + ((gi) & 3) * 16; \
            _Pragma("unroll") for (int b_ = 0; b_ < 2; ++b_) { const v4u w_ = *(const v4u*)(H + (size_t)row_ * DM + col0 + b_ * 128); \
                hv[slot][2 * b_] = (A4){bf_lo(w_.x), bf_hi(w_.x), bf_lo(w_.y), bf_hi(w_.y)}; hv[slot][2 * b_ + 1] = (A4){bf_lo(w_.z), bf_hi(w_.z), bf_lo(w_.w), bf_hi(w_.w)}; } } while (0)
        FIN_LOAD(0, 0);
#pragma unroll
        for (int gi = 0; gi < 8; ++gi) { const int ai = gi >> 2, m = gi & 3, row = row0 + ai * 128 + m * 16, sl = gi & 1;
            if (gi + 1 < 8) FIN_LOAD((gi + 1) & 1, gi + 1);
            float sq = 0.f;
#pragma unroll
            for (int bj = 0; bj < 2; ++bj)
#pragma unroll
                for (int n = 0; n < 2; ++n) { const A4 v = hv[sl][bj * 2 + n] + acc[ai][bj][m][n] * alpha; acc[ai][bj][m][n] = v; sq += (v[0] * v[0] + v[1] * v[1]) + (v[2] * v[2] + v[3] * v[3]); }
            sq += __shfl_xor(sq, 16); sq += __shfl_xor(sq, 32);
            if (fq == 0) ss_add(ss + row, sq); }
#undef FIN_LOAD
        asm volatile("s_waitcnt vmcnt(0)" ::: "memory");
        __syncthreads();
        if (threadIdx.x == 0) { unsigned* p = cnt + ((u.arow - NMETA) >> 8) * 16;
            __builtin_amdgcn_fence(__ATOMIC_RELEASE, "agent"); (void)xb_add(p, 1u);
            XB_SPIN(xb_ld(p) < 16u, bar);
            __builtin_amdgcn_fence(__ATOMIC_ACQUIRE, "agent"); }
        __syncthreads();
        float sv[8];
        { float t[8];
#pragma unroll
          for (int i = 0; i < 8; ++i) t[i] = (float)__hip_atomic_load(ss + row0 + (i >> 2) * 128 + (i & 3) * 16, RLX_AGENT) * (1.0f / SSFIX);
#pragma unroll
          for (int i = 0; i < 8; ++i) sv[i] = 1.0f / sqrtf(t[i] * (1.f / DM) + EPS); }
        A4 gv[2][2];
#pragma unroll
        for (int bj = 0; bj < 2; ++bj)
#pragma unroll
            for (int n = 0; n < 2; ++n) gv[bj][n] = *(const A4*)(gfin + col0 + bj * 128 + 4 * n);
#pragma unroll
        for (int gi = 0; gi < 8; ++gi) { const int ai = gi >> 2, m = gi & 3, row = row0 + ai * 128 + m * 16; const float s = sv[gi];
            float* op = out + (size_t)(row - NMETA) * DM + col0;
#pragma unroll
            for (int bj = 0; bj < 2; ++bj)
#pragma unroll
                for (int n = 0; n < 2; ++n) *(A4*)(op + bj * 128 + 4 * n) = acc[ai][bj][m][n] * s * gv[bj][n]; }
    }
};
struct EpiResidQ {
    bf16* H; const float* gnext; ssq_t* ss; unsigned* amax; unsigned char* A8; float* rs; unsigned* cnt; unsigned* bar;
    __device__ __forceinline__ void operator()(A4 (&acc)[2][2][4][2], const pg8::Unit& u, int wr, int wc, int fr, int fq) const {
        const int row0 = u.arow + wr * 64 + fr, col0 = u.pn * 256 + wc * 32 + 8 * fq;
        A4 gv[2][2];
#pragma unroll
        for (int bj = 0; bj < 2; ++bj)
#pragma unroll
            for (int n = 0; n < 2; ++n) gv[bj][n] = *(const A4*)(gnext + col0 + bj * 128 + 4 * n);
        A4 hv[2][4];
#define FIN_LOAD(slot, gi) do { const int row_ = row0 + ((gi) >> 2) * 128 + ((gi) & 3) * 16; \
            _Pragma("unroll") for (int b_ = 0; b_ < 2; ++b_) { const v4u w_ = *(const v4u*)(H + (size_t)row_ * DM + col0 + b_ * 128); \
                hv[slot][2 * b_] = (A4){bf_lo(w_.x), bf_hi(w_.x), bf_lo(w_.y), bf_hi(w_.y)}; hv[slot][2 * b_ + 1] = (A4){bf_lo(w_.z), bf_hi(w_.z), bf_lo(w_.w), bf_hi(w_.w)}; } } while (0)
        FIN_LOAD(0, 0);
#pragma unroll
        for (int gi = 0; gi < 8; ++gi) { const int ai = gi >> 2, m = gi & 3, row = row0 + ai * 128 + m * 16, sl = gi & 1;
            if (gi + 1 < 8) FIN_LOAD((gi + 1) & 1, gi + 1);
            float sq = 0.f, am = 0.f;
#pragma unroll
            for (int bj = 0; bj < 2; ++bj) { A4 v[2];
#pragma unroll
                for (int n = 0; n < 2; ++n) { v[n] = hv[sl][bj * 2 + n] + acc[ai][bj][m][n]; sq += (v[n][0] * v[n][0] + v[n][1] * v[n][1]) + (v[n][2] * v[n][2] + v[n][3] * v[n][3]);
                    const A4 p = v[n] * gv[bj][n]; acc[ai][bj][m][n] = p; am = fmaxf(am, fmaxf(fmaxf(fabsf(p[0]), fabsf(p[1])), fmaxf(fabsf(p[2]), fabsf(p[3])))); }
                v4u hw; hw.x = pk2(v[0][0], v[0][1]); hw.y = pk2(v[0][2], v[0][3]); hw.z = pk2(v[1][0], v[1][1]); hw.w = pk2(v[1][2], v[1][3]);
                *(v4u*)(H + (size_t)row * DM + col0 + bj * 128) = hw; }
            sq += __shfl_xor(sq, 16); sq += __shfl_xor(sq, 32); am = fmaxf(am, __shfl_xor(am, 16)); am = fmaxf(am, __shfl_xor(am, 32));
            if (fq == 0) { ss_add(ss + row, sq); atomicMax(amax + row, __float_as_uint(am)); } }
#undef FIN_LOAD
        asm volatile("s_waitcnt vmcnt(0)" ::: "memory");
        __syncthreads();
        if (threadIdx.x == 0) { unsigned* p = cnt + ((u.arow - NMETA) >> 8) * 16;
            __builtin_amdgcn_fence(__ATOMIC_RELEASE, "agent"); (void)xb_add(p, 1u);
            XB_SPIN(xb_ld(p) < 16u, bar);
            __builtin_amdgcn_fence(__ATOMIC_ACQUIRE, "agent"); }
        __syncthreads();
        float av[8];
#pragma unroll
        for (int i = 0; i < 8; ++i) av[i] = __uint_as_float(__hip_atomic_load(amax + row0 + (i >> 2) * 128 + (i & 3) * 16, RLX_AGENT));
        if (u.pn == 0 && wc == 0 && fq == 0) {
#pragma unroll
            for (int i = 0; i < 8; ++i) { const int row = row0 + (i >> 2) * 128 + (i & 3) * 16; rs[row] = av[i] * (1.0f / 127.0f) / sqrtf((float)__hip_atomic_load(ss + row, RLX_AGENT) * (1.f / (DM * SSFIX)) + EPS); } }
#pragma unroll
        for (int gi = 0; gi < 8; ++gi) { const int ai = gi >> 2, m = gi & 3, row = row0 + ai * 128 + m * 16; const float sc = av[gi] > 0.f ? 127.0f / av[gi] : 0.f;
#pragma unroll
            for (int bj = 0; bj < 2; ++bj) { const A4 p = acc[ai][bj][m][0] * sc, q = acc[ai][bj][m][1] * sc; v2u o; o.x = pack4_i8(p[0], p[1], p[2], p[3]); o.y = pack4_i8(q[0], q[1], q[2], q[3]);
                *(v2u*)(A8 + (size_t)row * DM + col0 + bj * 128) = o; } }
    }
};
struct EpiSwiGLUQ {
    bf16* O; const float* rs; const float* wmax;
    __device__ __forceinline__ void operator()(const A4 (&acc)[2][2][4][2], const pg8::Unit& u, int wr, int wc, int fr, int fq) const {
        const int row0 = u.arow + wr * 64 + fr, col0 = u.pn * 128 + wc * 32 + 8 * fq;
        float sv[8];
#pragma unroll
        for (int i = 0; i < 8; ++i) sv[i] = rs[row0 + (i >> 2) * 128 + (i & 3) * 16];
        A4 wv[2][2];
#pragma unroll
        for (int bj = 0; bj < 2; ++bj)
#pragma unroll
            for (int n = 0; n < 2; ++n) wv[bj][n] = *(const A4*)(wmax + u.pn * 256 + bj * 128 + wc * 32 + 8 * fq + 4 * n) * (1.0f / 127.0f);
#pragma unroll
        for (int ai = 0; ai < 2; ++ai)
#pragma unroll
            for (int m = 0; m < 4; ++m) { const int row = row0 + ai * 128 + m * 16; const float s = sv[ai * 4 + m];
                const A4 a0 = acc[ai][0][m][0] * s * wv[0][0], a1 = acc[ai][0][m][1] * s * wv[0][1], b0 = acc[ai][1][m][0] * s * wv[1][0], b1 = acc[ai][1][m][1] * s * wv[1][1];
                v4u w; w.x = pk2(siluf_fast(a0[0]) * b0[0], siluf_fast(a0[1]) * b0[1]); w.y = pk2(siluf_fast(a0[2]) * b0[2], siluf_fast(a0[3]) * b0[3]);
                w.z = pk2(siluf_fast(a1[0]) * b1[0], siluf_fast(a1[1]) * b1[1]); w.w = pk2(siluf_fast(a1[2]) * b1[2], siluf_fast(a1[3]) * b1[3]);
                *(v4u*)(O + (size_t)row * DFF + col0) = w; }
    }
};
struct EpiWin {
    const ssq_t* ss; unsigned char* ws;
    __device__ __forceinline__ void operator()(const A4 (&acc)[2][2][4][2], const pg8::Unit& u, int wr, int wc, int fr, int fq) const {
        const int row0 = u.arow + wr * 64 + fr, pn = u.pn;
        if (pn == 48) {
            if (wc == 0) { float* SM = (float*)(ws + WS_SM) + 8 * fq;
#pragma unroll
                for (int ai = 0; ai < 2; ++ai)
#pragma unroll
                    for (int m = 0; m < 4; ++m) { const int row = row0 + ai * 128 + m * 16; const float s = rstd_of(ss, row);
                        *(A4*)(SM + (size_t)row * 32) = acc[ai][0][m][0] * s; *(A4*)(SM + (size_t)row * 32 + 4) = acc[ai][0][m][1] * s; } }
            return; }
        size_t boff; int ldrow, bjs; float mul = 1.f; bool act = false;
        if (pn < 24) { boff = WS_FQ + (size_t)(pn >> 3) * (WS_FK - WS_FQ) + (size_t)(2 * (pn & 7)) * LP * FOXD * 2; ldrow = FOXD; bjs = LP * FOXD; }
        else if (pn < 28) { boff = WS_GQ + (size_t)(pn - 24) * 512; ldrow = GKW; bjs = 128; mul = 0.0625f; }
        else if (pn < 32) { boff = WS_GK + (size_t)(pn - 28) * 512; ldrow = GKW; bjs = 128; }
        else if (pn < 40) { boff = WS_GV + (size_t)(pn - 32) * 512; ldrow = GVW; bjs = 128; }
        else { boff = WS_GR + (size_t)(pn - 40) * 512; ldrow = GVW; bjs = 128; act = true; }
        char* basec = (char*)ws + boff + (wc * 32 + 8 * fq) * 2;
        float sv[8]; rstd8(ss, row0, sv);
#pragma unroll
        for (int ai = 0; ai < 2; ++ai)
#pragma unroll
            for (int m = 0; m < 4; ++m) { const int row = row0 + ai * 128 + m * 16; const float s = sv[ai * 4 + m] * mul;
#pragma unroll
                for (int bj = 0; bj < 2; ++bj) { A4 a0 = acc[ai][bj][m][0] * s, a1 = acc[ai][bj][m][1] * s;
                    if (act) {
#pragma unroll
                        for (int j = 0; j < 4; ++j) { a0[j] = siluf_fast(a0[j]); a1[j] = siluf_fast(a1[j]); } }
                    v4u w; w.x = pk2(a0[0], a0[1]); w.y = pk2(a0[2], a0[3]); w.z = pk2(a1[0], a1[1]); w.w = pk2(a1[2], a1[3]);
                    *(v4u*)(basec + (size_t)(unsigned)((row * ldrow + bj * bjs) * 2)) = w; }
                asm volatile("" ::: "memory"); }
    }
};
struct EpiGate {
    const float* rs; const float* wmax; bf16* GA; bf16* GB; int nai;
    __device__ __forceinline__ void operator()(const A4 (&acc)[2][2][4][2], const pg8::Unit& u, int wr, int wc, int fr, int fq) const {
        const int row0 = u.arow + wr * 64 + fr, col0 = u.pn * 128 + wc * 32 + 8 * fq;
        float sv[8];
#pragma unroll
        for (int i = 0; i < 8; ++i) sv[i] = rs[row0 + (i >> 2) * 128 + (i & 3) * 16];
        A4 wv[2][2];
#pragma unroll
        for (int bj = 0; bj < 2; ++bj)
#pragma unroll
            for (int n = 0; n < 2; ++n) wv[bj][n] = *(const A4*)(wmax + u.pn * 256 + bj * 128 + wc * 32 + 8 * fq + 4 * n) * (1.0f / 127.0f);
#pragma unroll
        for (int ai = 0; ai < 2; ++ai)
#pragma unroll
            for (int m = 0; m < 4; ++m) { if (ai >= nai) continue; const int row = row0 + ai * 128 + m * 16; const float s = sv[ai * 4 + m];
#pragma unroll
                for (int bj = 0; bj < 2; ++bj) { const A4 a0 = acc[ai][bj][m][0] * s * wv[bj][0], a1 = acc[ai][bj][m][1] * s * wv[bj][1];
                    v4u w; w.x = pk2(sigmoidf_fast(a0[0]), sigmoidf_fast(a0[1])); w.y = pk2(sigmoidf_fast(a0[2]), sigmoidf_fast(a0[3]));
                    w.z = pk2(sigmoidf_fast(a1[0]), sigmoidf_fast(a1[1])); w.w = pk2(sigmoidf_fast(a1[2]), sigmoidf_fast(a1[3]));
                    *(v4u*)((bj == 0 ? GA : GB) + (size_t)row * DM + col0) = w; } }
    }
};
struct HalfOrder { int c;
    __device__ bool next(int i, pg8::Unit& u) const { if (i > 0) return false; u.arow = 28 * 256 + 128 * (c >> 5); u.brow = 256 * (c & 31); u.pn = c & 31; return true; } };
template <int PASS> struct EpiProj {
    const bf16* Gt; bf16* Y; bf16* YBF;
    __device__ __forceinline__ void operator()(const A4 (&acc)[2][2][4][2], const pg8::Unit& u, int wr, int wc, int fr, int fq) const {
        const int row0 = u.arow + wr * 64 + fr, col0 = u.pn * 256 + wc * 32 + 8 * fq;
#pragma unroll
        for (int ai = 0; ai < 2; ++ai)
#pragma unroll
            for (int m = 0; m < 4; ++m) { const int row = row0 + ai * 128 + m * 16;
#pragma unroll
                for (int bj = 0; bj < 2; ++bj) { const size_t off = (size_t)row * DM + col0 + bj * 128;
                    const v4u gw = *(const v4u*)(Gt + off);
                    const A4 g0 = {bf_lo(gw.x), bf_hi(gw.x), bf_lo(gw.y), bf_hi(gw.y)}, g1 = {bf_lo(gw.z), bf_hi(gw.z), bf_lo(gw.w), bf_hi(gw.w)};
                    A4 y0 = g0 * acc[ai][bj][m][0], y1 = g1 * acc[ai][bj][m][1];
                    if (PASS == 1) { const v4u yw = *(const v4u*)(Y + off); y0 += (A4){bf_lo(yw.x), bf_hi(yw.x), bf_lo(yw.y), bf_hi(yw.y)}; y1 += (A4){bf_lo(yw.z), bf_hi(yw.z), bf_lo(yw.w), bf_hi(yw.w)}; }
                    v4u w; w.x = pk2(y0[0], y0[1]); w.y = pk2(y0[2], y0[3]); w.z = pk2(y1[0], y1[1]); w.w = pk2(y1[2], y1[3]);
                    *(v4u*)((PASS == 0 ? Y : YBF) + off) = w; }
                if (m & 1) asm volatile("" ::: "memory"); }
    }
};
constexpr int TAIL0 = 8192;
template <int NT>
__device__ __forceinline__ void skinny_tile(Frame& F, const bf16* S, int lds_, const bf16* T0, const bf16* T1, int ldt, int K, float& d0, float& d1) {
    typedef float f4 __attribute__((ext_vector_type(4)));
    LAS float* red = (LAS float*)(F.lds + RING_OFF);
    const int lane = F.lane, r = lane & 15, kq = lane >> 4, kslice = K / NWAVES, k0 = F.wave * kslice + 8 * kq;
    const bf16* sp = S + (size_t)r * lds_ + k0; const bf16* t0p = T0 + (size_t)r * ldt + k0; const bf16* t1p = T1 + (size_t)r * ldt + k0;
    f4 a0 = {0.f, 0.f, 0.f, 0.f}, a1 = {0.f, 0.f, 0.f, 0.f};
#pragma unroll 8
    for (int ks = 0; ks < kslice / 32; ++ks) { const bf16x8 sv = *(const bf16x8*)(sp + 32 * ks); const bf16x8 tv0 = *(const bf16x8*)(t0p + 32 * ks);
        a0 = __builtin_amdgcn_mfma_f32_16x16x32_bf16(tv0, sv, a0, 0, 0, 0);
        if (NT == 2) { const bf16x8 tv1 = *(const bf16x8*)(t1p + 32 * ks); a1 = __builtin_amdgcn_mfma_f32_16x16x32_bf16(tv1, sv, a1, 0, 0, 0); } }
    __syncthreads();
    *(LAS f4*)(red + (F.wave * NT + 0) * 256 + lane * 4) = a0;
    if (NT == 2) *(LAS f4*)(red + (F.wave * NT + 1) * 256 + lane * 4) = a1;
    __syncthreads();
    d0 = 0.f; d1 = 0.f;
    if (F.tid < 256) {
#pragma unroll
        for (int w = 0; w < NWAVES; ++w) { d0 += red[(w * NT + 0) * 256 + F.tid]; if (NT == 2) d1 += red[(w * NT + 1) * 256 + F.tid]; } }
}
template <int NT>
__device__ __forceinline__ void skinny_tile8(Frame& F, const unsigned char* S, const unsigned char* T0, const unsigned char* T1, int K, float& d0, float& d1) {
    LAS int* red = (LAS int*)(F.lds + RING_OFF);
    const int lane = F.lane, r = lane & 15, kq = lane >> 4, kslice = K / NWAVES, k0 = F.wave * kslice + 16 * kq;
    const unsigned char* sp = S + (size_t)r * K + k0; const unsigned char* t0p = T0 + (size_t)r * K + k0; const unsigned char* t1p = T1 + (size_t)r * K + k0;
    pg8::i32x4 a0 = {0, 0, 0, 0}, a1 = {0, 0, 0, 0};
#pragma unroll 8
    for (int ks = 0; ks < kslice / 64; ++ks) { const pg8::i32x4 sv = *(const pg8::i32x4*)(sp + 64 * ks); const pg8::i32x4 tv0 = *(const pg8::i32x4*)(t0p + 64 * ks);
        a0 = __builtin_amdgcn_mfma_i32_16x16x64_i8(tv0, sv, a0, 0, 0, 0);
        if (NT == 2) { const pg8::i32x4 tv1 = *(const pg8::i32x4*)(t1p + 64 * ks); a1 = __builtin_amdgcn_mfma_i32_16x16x64_i8(tv1, sv, a1, 0, 0, 0); } }
    __syncthreads();
    *(LAS pg8::i32x4*)(red + (F.wave * NT + 0) * 256 + lane * 4) = a0;
    if (NT == 2) *(LAS pg8::i32x4*)(red + (F.wave * NT + 1) * 256 + lane * 4) = a1;
    __syncthreads();
    int e0 = 0, e1 = 0;
    if (F.tid < 256) {
#pragma unroll
        for (int w = 0; w < NWAVES; ++w) { e0 += red[(w * NT + 0) * 256 + F.tid]; if (NT == 2) e1 += red[(w * NT + 1) * 256 + F.tid]; } }
    d0 = (float)e0; d1 = (float)e1;
}
__device__ __forceinline__ void skinny_p1(Frame& F, const unsigned char* n18, const float* rs, const unsigned char* W1A8, const float* wmax, bf16* HIDo) {
    for (int hb = (int)blockIdx.x; hb < DFF / 16; hb += F.G) { const int r1 = 256 * (hb >> 3) + 16 * (hb & 7); float a, b;
        skinny_tile8<2>(F, n18 + (size_t)TAIL0 * DM, W1A8 + (size_t)r1 * DM, W1A8 + (size_t)(r1 + 128) * DM, DM, a, b);
        if (F.tid < 256) { const int i = 4 * (F.tid >> 6) + (F.tid & 3), j = (F.tid >> 2) & 15; const float s = rs[TAIL0 + j] * (1.0f / 127.0f); a *= s * wmax[r1 + i]; b *= s * wmax[r1 + 128 + i];
            HIDo[(size_t)(TAIL0 + j) * DFF + 16 * hb + i] = (bf16)(pk2(siluf_fast(a) * b, 0.f) & 0xffffu); } }
    __syncthreads();
}
__device__ __forceinline__ void skinny_p2(Frame& F, const Args& A, const bf16* HIDi, const bf16* W1Bi, bf16* Ho, bf16* ABo, ssq_t* SS) {
    for (int cbk = (int)blockIdx.x; cbk < DM / 16; cbk += F.G) { float v, dummy;
        skinny_tile<1>(F, HIDi + (size_t)TAIL0 * DFF, DFF, W1Bi + (size_t)(16 * cbk) * DFF, W1Bi, DFF, DFF, v, dummy);
        if (F.tid < 256) { const int i = 4 * (F.tid >> 6) + (F.tid & 3), j = (F.tid >> 2) & 15, pos = TAIL0 + j, col = 16 * cbk + i;
            const float h1 = A.in[I_X][(size_t)(pos - NMETA) * DM + col] + 0.5f * v;
            Ho[(size_t)pos * DM + col] = (bf16)(pk2(h1, 0.f) & 0xffffu); ABo[(size_t)pos * DM + col] = (bf16)(pk2(h1 * A.in[I_NMIXG][col], 0.f) & 0xffffu);
            float sq = h1 * h1; sq += __shfl_xor(sq, 1); sq += __shfl_xor(sq, 2);
            if ((F.tid & 3) == 0) ss_add(SS + pos, sq); } }
    __syncthreads();
}
__device__ __forceinline__ void skinny_p3(Frame& F, const bf16* a2, const bf16* WINi, const ssq_t* SS) {
    unsigned char* ws = F.ws;
    constexpr int NB_TAIL = 770, NB_SMALL = TAIL0 / 16;
    for (int b = (int)blockIdx.x; b < NB_TAIL + NB_SMALL; b += F.G) {
        if (b < NB_TAIL) { const int row0 = 16 * b; float v, dummy;
            skinny_tile<1>(F, a2 + (size_t)TAIL0 * DM, DM, WINi + (size_t)row0 * DM, WINi, DM, DM, v, dummy);
            if (F.tid < 256) { const int i = 4 * (F.tid >> 6) + (F.tid & 3), j = (F.tid >> 2) & 15, pos = TAIL0 + j; const float s = rstd_of(SS, pos); v *= s;
                if (row0 < 6144) { const int T = row0 >> 11, head = (row0 & 2047) >> 7, d = (row0 & 127) + i;
                    ((bf16*)(ws + WS_FQ + (size_t)T * (WS_FK - WS_FQ)))[((size_t)head * LP + pos) * FOXD + d] = (bf16)(pk2(v, 0.f) & 0xffffu); }
                else if (row0 < 7168) ((bf16*)(ws + WS_GQ))[(size_t)pos * GKW + (row0 - 6144) + i] = (bf16)(pk2(v * 0.0625f, 0.f) & 0xffffu);
                else if (row0 < 8192) ((bf16*)(ws + WS_GK))[(size_t)pos * GKW + (row0 - 7168) + i] = (bf16)(pk2(v, 0.f) & 0xffffu);
                else if (row0 < 10240) ((bf16*)(ws + WS_GV))[(size_t)pos * GVW + (row0 - 8192) + i] = (bf16)(pk2(v, 0.f) & 0xffffu);
                else if (row0 < 12288) ((bf16*)(ws + WS_GR))[(size_t)pos * GVW + (row0 - 10240) + i] = (bf16)(pk2(siluf_fast(v), 0.f) & 0xffffu);
                else ((float*)(ws + WS_SM))[(size_t)pos * 32 + (row0 - 12288) + i] = v; } }
        else { const int tb = b - NB_TAIL; float v0, v1;
            skinny_tile<2>(F, a2 + (size_t)(16 * tb) * DM, DM, WINi + (size_t)WIN_SMALL * DM, WINi + (size_t)(WIN_SMALL + 16) * DM, DM, DM, v0, v1);
            if (F.tid < 256) { const int i = 4 * (F.tid >> 6) + (F.tid & 3), j = (F.tid >> 2) & 15, pos = 16 * tb + j; const float s = rstd_of(SS, pos);
                float* SMp = (float*)(ws + WS_SM) + (size_t)pos * 32; SMp[i] = v0 * s; SMp[16 + i] = v1 * s; } } }
    { const size_t gt = (size_t)blockIdx.x * 512 + F.tid, NTH = (size_t)F.G * 512; constexpr int PADR = LP - L;
      for (size_t e = gt; e < (size_t)3 * FOXH * PADR * (FOXD / 8); e += NTH) { const int c8 = (int)(e % (FOXD / 8)); const size_t rr = e / (FOXD / 8); const int pr = (int)(rr % PADR); const int th = (int)(rr / PADR);
          *(v4u*)((bf16*)(ws + WS_FQ) + ((size_t)th * LP + L + pr) * FOXD + 8 * c8) = (v4u){0u, 0u, 0u, 0u}; }
      for (size_t e = gt; e < (size_t)PADR * 32; e += NTH) ((float*)(ws + WS_SM))[(size_t)L * 32 + e] = 0.f; }
    __syncthreads();
}

__device__ __forceinline__ void skinny_gates(Frame& F) {
    unsigned char* ws = F.ws; const unsigned char* A8 = ws + WS_A8; const unsigned char* WG8 = ws + WS_WG8; const float* rs = (const float*)(ws + WS_RS2); const float* wmax = (const float*)(ws + WS_WCLIP) + WCH_G;
    for (int b = (int)blockIdx.x; b < 512; b += F.G) { const int row0 = 16 * b; float v;
        float dummy; skinny_tile8<1>(F, A8 + (size_t)TAIL0 * DM, WG8 + (size_t)row0 * DM, WG8, DM, v, dummy);
        if (F.tid < 256) { const int i = 4 * (F.tid >> 6) + (F.tid & 3), j = (F.tid >> 2) & 15, pos = TAIL0 + j; v *= rs[pos] * wmax[row0 + i] * (1.0f / 127.0f);
            const int t = row0 >> 8, within = row0 & 255; bf16* G = (bf16*)(ws + (within < 128 ? WS_GA : WS_GB));
            G[(size_t)pos * DM + 128 * t + (within & 127) + i] = (bf16)(pk2(sigmoidf_fast(v), 0.f) & 0xffffu); } }
    __syncthreads();
}
__device__ __forceinline__ void quant_rows(Frame& F, const bf16* src, const ssq_t* ss, unsigned char* dst, float* rs, int nrows, int wv, int nwv) {
    const int lane = lane_id_fresh(); const int gw = (int)blockIdx.x * nwv + wv, NGW = F.G * nwv;
    for (int r = gw; r < nrows; r += NGW) { const v4u* sp = (const v4u*)(src + (size_t)r * DM) + lane; v4u w[8]; float am = 0.f;
#pragma unroll
        for (int j = 0; j < 8; ++j) { w[j] = sp[64 * j];
            am = fmaxf(am, fmaxf(fmaxf(fabsf(bf_lo(w[j].x)), fabsf(bf_hi(w[j].x))), fmaxf(fabsf(bf_lo(w[j].y)), fabsf(bf_hi(w[j].y)))));
            am = fmaxf(am, fmaxf(fmaxf(fabsf(bf_lo(w[j].z)), fabsf(bf_hi(w[j].z))), fmaxf(fabsf(bf_lo(w[j].w)), fabsf(bf_hi(w[j].w))))); }
#pragma unroll
        for (int o = 1; o < 64; o <<= 1) am = fmaxf(am, __shfl_xor(am, o));
        const float sc = am > 0.f ? 127.0f / am : 0.f;
        v2u* dp = (v2u*)(dst + (size_t)r * DM) + lane;
#pragma unroll
        for (int j = 0; j < 8; ++j) { v2u o; o.x = pack4_i8(bf_lo(w[j].x) * sc, bf_hi(w[j].x) * sc, bf_lo(w[j].y) * sc, bf_hi(w[j].y) * sc); o.y = pack4_i8(bf_lo(w[j].z) * sc, bf_hi(w[j].z) * sc, bf_lo(w[j].w) * sc, bf_hi(w[j].w) * sc);
            dp[64 * j] = o; }
        if (lane == 0) rs[r] = am * (1.0f / 127.0f) * rstd_of(ss, r); }
}

__device__ __forceinline__ void prep_fox_cumsum(Frame& F, const Args& A, int h) {
    const float* lf = (const float*)(F.ws + WS_SM) + h; float* cb = (float*)(F.ws + WS_CB) + (size_t)h * LP;
    LAS float* wsum = (LAS float*)(F.lds + RING_OFF);
    const int base = 17 * F.tid; float v[17]; float run = 0.f; const float fb = A.in[I_FBIAS][h];
#pragma unroll
    for (int j = 0; j < 17; ++j) { const int idx = base + j; const float t = idx < LP ? log_sigmoidf_acc(lf[(size_t)idx * 32] + fb) : 0.f; run += t; v[j] = run; }
    float inc = run;
#pragma unroll
    for (int o = 1; o < 64; o <<= 1) { const float t = __shfl_up(inc, o); if (F.lane >= o) inc += t; }
    if (F.lane == 63) wsum[F.wave] = inc;
    __syncthreads();
    float pre = inc - run;
    for (int w = 0; w < F.wave; ++w) pre += wsum[w];
    constexpr float INVS = -11.313708498984761f;
#pragma unroll
    for (int j = 0; j < 17; ++j) { const int idx = base + j; if (idx < LP) cb[idx] = (pre + v[j]) * INVS; }
    __syncthreads();
}
__device__ __forceinline__ void prep_gla_item(Frame& F, const Args& A, int ci, int h, int parts) {
    const float* SMd = (const float*)(F.ws + WS_SM) + 16; const bf16* GK = (const bf16*)(F.ws + WS_GK); const bf16* GV = (const bf16*)(F.ws + WS_GV);
    bf16* KDT = (bf16*)(F.ws + WS_KDT) + (size_t)(h * NCHUNK + ci) * GDK * CHUNK; bf16* VT = (bf16*)(F.ws + WS_VT) + (size_t)(h * NCHUNK + ci) * GDV * CHUNK;
    float* GG = (float*)(F.ws + WS_GG) + (size_t)(ci * GLAH + h) * GDK;
    LAS float* abl = (LAS float*)(F.lds + RING_OFF);
    LAS float* tot = abl + 1024;
    const int p0 = ci * CHUNK - PADL;
    const int k = F.tid & 255, half = F.tid >> 8, kg = h * GDK + k;
    unsigned vr[64], kr[32]; float w[16], ab0 = 0.f, ab1 = 0.f, bb = 0.f;
    if (parts & 2) {
#pragma unroll
        for (int c = 0; c < 64; ++c) { const int p = p0 + c; vr[c] = GV[(size_t)(p < 0 ? 0 : p) * GVW + h * GDV + F.tid]; } }
    if (parts & 1) {
        { const int c = F.tid >> 4, p = p0 + c; ab0 = SMd[(size_t)(p < 0 ? 0 : p) * 32 + (F.tid & 15)]; if (p < 0) ab0 = 0.f; }
        { const int c = 32 + (F.tid >> 4), p = p0 + c; ab1 = SMd[(size_t)(p < 0 ? 0 : p) * 32 + (F.tid & 15)]; if (p < 0) ab1 = 0.f; }
#pragma unroll
        for (int r = 0; r < 16; ++r) w[r] = A.in[I_AW2][(size_t)r * GKW + kg];
        bb = A.in[I_AB][kg];
#pragma unroll
        for (int cc = 0; cc < 32; ++cc) { const int p = p0 + 32 * half + cc; kr[cc] = GK[(size_t)(p < 0 ? 0 : p) * GKW + kg]; } }
    if (parts & 1) {
    abl[F.tid] = ab0; abl[F.tid + 512] = ab1;
    __syncthreads();
    float cum[32]; float run = 0.f;
#pragma unroll
    for (int cc = 0; cc < 32; ++cc) { const int c = 32 * half + cc; float z = bb;
#pragma unroll
        for (int r4 = 0; r4 < 4; ++r4) { const f32x4 a4 = *(const LAS f32x4*)(abl + c * 16 + 4 * r4); z += a4[0] * w[4 * r4] + a4[1] * w[4 * r4 + 1] + a4[2] * w[4 * r4 + 2] + a4[3] * w[4 * r4 + 3]; }
        const float la = (p0 + c >= 0) ? log_sigmoidf_fast(z) * 0.0625f : 0.f; run += la; cum[cc] = run; }
    tot[half * 256 + k] = run;
    __syncthreads();
    const float t0 = tot[k], t1 = tot[256 + k], rem = half ? t1 : t0 + t1;
    if (half == 0) GG[k] = expf_fast(t0 + t1);
    unsigned pk[16];
#pragma unroll
    for (int cc = 0; cc < 32; cc += 2) { const int c = 32 * half + cc;
        const float k0v = (p0 + c >= 0) ? __uint_as_float(kr[cc] << 16) : 0.f, k1v = (p0 + c + 1 >= 0) ? __uint_as_float(kr[cc + 1] << 16) : 0.f;
        pk[cc >> 1] = pk2(k0v * expf_fast(rem - cum[cc]), k1v * expf_fast(rem - cum[cc + 1])); }
    { v4u* dst = (v4u*)(KDT + (size_t)k * CHUNK + 32 * half);
#pragma unroll
      for (int q = 0; q < 4; ++q) { v4u o; o.x = pk[4 * q]; o.y = pk[4 * q + 1]; o.z = pk[4 * q + 2]; o.w = pk[4 * q + 3]; dst[q] = o; } }
    }
    if (parts & 2) { unsigned pv[32];
#pragma unroll
      for (int c = 0; c < 64; c += 2) { const unsigned lo = (p0 + c >= 0) ? vr[c] : 0u, hi = (p0 + c + 1 >= 0) ? vr[c + 1] : 0u; pv[c >> 1] = lo | (hi << 16); }
      v4u* dst = (v4u*)(VT + (size_t)F.tid * CHUNK);
#pragma unroll
      for (int q = 0; q < 8; ++q) { v4u o; o.x = pv[4 * q]; o.y = pv[4 * q + 1]; o.z = pv[4 * q + 2]; o.w = pv[4 * q + 3]; dst[q] = o; } }
    __syncthreads();
}

__device__ __forceinline__ void sub_bar4(volatile LAS unsigned* ctr, unsigned& phase, int lane) {
    __builtin_amdgcn_fence(__ATOMIC_RELEASE, "workgroup");
    ++phase;
    if (lane == 0) (void)__hip_atomic_fetch_add((LAS unsigned*)ctr, 1u, __ATOMIC_RELAXED, __HIP_MEMORY_SCOPE_WORKGROUP);
    while (*ctr < 4u * phase) __builtin_amdgcn_s_sleep(1);
    __builtin_amdgcn_fence(__ATOMIC_ACQUIRE, "workgroup");
}
__device__ __forceinline__ void prep_gla_item4(Frame& F, const Args& A, int ci, int h, int buf, unsigned& phase) {
    const float* SMd = (const float*)(F.ws + WS_SM) + 16; const bf16* GK = (const bf16*)(F.ws + WS_GK); const bf16* GV = (const bf16*)(F.ws + WS_GV);
    bf16* KDT = (bf16*)(F.ws + WS_KDT) + (size_t)(h * NCHUNK + ci) * GDK * CHUNK; bf16* VT = (bf16*)(F.ws + WS_VT) + (size_t)(h * NCHUNK + ci) * GDV * CHUNK;
    float* GG = (float*)(F.ws + WS_GG) + (size_t)(ci * GLAH + h) * GDK;
    LAS float* abl = (LAS float*)(F.lds + RING_OFF) + buf * 1024;
    const int p0 = ci * CHUNK - PADL, t = F.tid, kg = h * GDK + t, lane = t & 63;
    float ab[4], w[16]; unsigned kr[64];
#pragma unroll
    for (int q = 0; q < 4; ++q) { const int i = t + 256 * q, p = p0 + (i >> 4); ab[q] = SMd[(size_t)(p < 0 ? 0 : p) * 32 + (i & 15)]; if (p < 0) ab[q] = 0.f; }
#pragma unroll
    for (int r = 0; r < 16; ++r) w[r] = A.in[I_AW2][(size_t)r * GKW + kg];
    const float bb = A.in[I_AB][kg];
#pragma unroll
    for (int c = 0; c < 64; ++c) { const int p = p0 + c; kr[c] = GK[(size_t)(p < 0 ? 0 : p) * GKW + kg]; }
#pragma unroll
    for (int q = 0; q < 4; ++q) abl[t + 256 * q] = ab[q];
    sub_bar4(F.MISC + 24, phase, lane);
    float cum[64]; float run = 0.f;
#pragma unroll
    for (int c = 0; c < 64; ++c) { float z = bb;
#pragma unroll
        for (int r4 = 0; r4 < 4; ++r4) { const f32x4 a4 = *(const LAS f32x4*)(abl + c * 16 + 4 * r4); z += a4[0] * w[4 * r4] + a4[1] * w[4 * r4 + 1] + a4[2] * w[4 * r4 + 2] + a4[3] * w[4 * r4 + 3]; }
        const float la = (p0 + c >= 0) ? log_sigmoidf_fast(z) * 0.0625f : 0.f; run += la; cum[c] = run; }
    GG[t] = expf_fast(run);
    { v4u* dst = (v4u*)(KDT + (size_t)t * CHUNK);
#pragma unroll
      for (int q = 0; q < 8; ++q) { unsigned pk[4];
#pragma unroll
          for (int e = 0; e < 4; ++e) { const int c = 8 * q + 2 * e;
              const float k0v = (p0 + c >= 0) ? __uint_as_float(kr[c] << 16) : 0.f, k1v = (p0 + c + 1 >= 0) ? __uint_as_float(kr[c + 1] << 16) : 0.f;
              pk[e] = pk2(k0v * expf_fast(run - cum[c]), k1v * expf_fast(run - cum[c + 1])); }
          v4u o; o.x = pk[0]; o.y = pk[1]; o.z = pk[2]; o.w = pk[3]; dst[q] = o; } }
#pragma unroll
    for (int vh = 0; vh < 2; ++vh) { const int v = t + 256 * vh; unsigned vr[64];
#pragma unroll
        for (int c = 0; c < 64; ++c) { const int p = p0 + c; vr[c] = GV[(size_t)(p < 0 ? 0 : p) * GVW + h * GDV + v]; }
        v4u* dst = (v4u*)(VT + (size_t)v * CHUNK);
#pragma unroll
        for (int q = 0; q < 8; ++q) { unsigned pv[4];
#pragma unroll
            for (int e = 0; e < 4; ++e) { const int c = 8 * q + 2 * e; const unsigned lo = (p0 + c >= 0) ? vr[c] : 0u, hi = (p0 + c + 1 >= 0) ? vr[c + 1] : 0u; pv[e] = lo | (hi << 16); }
            v4u o; o.x = pv[0]; o.y = pv[1]; o.z = pv[2]; o.w = pv[3]; dst[q] = o; } }
}

__device__ __forceinline__ void prep_fox_cumsum4(Frame& F, const Args& A, int h, unsigned& phase) {
    const float* lf = (const float*)(F.ws + WS_SM) + h; float* cb = (float*)(F.ws + WS_CB) + (size_t)h * LP;
    LAS float* wsum = (LAS float*)(F.lds + RING_OFF + 8192);
    const int t = F.tid, lane = t & 63, base = 33 * t; float v[33]; float run = 0.f; const float fb = A.in[I_FBIAS][h];
#pragma unroll
    for (int j = 0; j < 33; ++j) { run += log_sigmoidf_acc(lf[(size_t)(base + j) * 32] + fb); v[j] = run; }
    float inc = run;
#pragma unroll
    for (int o = 1; o < 64; o <<= 1) { const float u = __shfl_up(inc, o); if (lane >= o) inc += u; }
    if (lane == 63) wsum[F.wave] = inc;
    sub_bar4(F.MISC + 24, phase, lane);
    float pre = inc - run;
    for (int w = 0; w < F.wave; ++w) pre += wsum[w];
    constexpr float INVS = -11.313708498984761f;
#pragma unroll
    for (int j = 0; j < 33; ++j) cb[base + j] = (pre + v[j]) * INVS;
}
__device__ __forceinline__ void prep_fox_norms(Frame& F, int item, int vtid) {
    const int rb = item % 33, th = item / 33, t = th & 1, h = th >> 1;
    const bf16* base = (const bf16*)(F.ws + (t == 0 ? WS_FQ : WS_FK)) + ((size_t)h * LP + (size_t)rb * 256) * FOXD;
    const v4u* rp = (const v4u*)(base + (size_t)(vtid >> 1) * FOXD + (vtid & 1) * 64); float s = 0.f;
#pragma unroll
    for (int q = 0; q < 8; ++q) { const v4u w = rp[q]; s += bf_lo(w.x) * bf_lo(w.x) + bf_hi(w.x) * bf_hi(w.x) + bf_lo(w.y) * bf_lo(w.y) + bf_hi(w.y) * bf_hi(w.y)
                                                        + bf_lo(w.z) * bf_lo(w.z) + bf_hi(w.z) * bf_hi(w.z) + bf_lo(w.w) * bf_lo(w.w) + bf_hi(w.w) * bf_hi(w.w); }
    s += __shfl_xor(s, 1);
#pragma unroll
    for (int o = 2; o < 64; o <<= 1) s = fmaxf(s, __shfl_xor(s, o));
    if (F.lane == 0) atomicMax(F.ctl + CW_QKN + 2 * h + t, __float_as_uint(s));
}

constexpr int GL_PITCH = 144, GL_KD_OFF = 0, GL_Q_OFF = 64 * GL_PITCH  , GL_VT_OFF = 2 * 64 * GL_PITCH  , GL_G_OFF = GL_VT_OFF + 256 * GL_PITCH  , GL_BUF = GL_G_OFF + 256  ;
static_assert(2 * GL_BUF <= RING_BYTES, "GLA LDS");
constexpr int GLA_WGS = 32;
__device__ __forceinline__ void gla_compute(LAS unsigned char* tb, f32x16 (&st)[2], bf16* OP, int p0, int w, int r32, int hi) {
    bf16x8 vt[4];
#pragma unroll
    for (int ks = 0; ks < 4; ++ks) vt[ks] = *(const LAS bf16x8*)(tb + GL_VT_OFF + (32 * w + r32) * GL_PITCH + (16 * ks + 8 * hi) * 2);
#pragma unroll
    for (int kb = 0; kb < 2; ++kb) {
#pragma unroll
        for (int gI = 0; gI < 4; ++gI) { const f32x4 gg = *(const LAS f32x4*)(tb + GL_G_OFF + (32 * kb + 8 * gI + 4 * hi) * 4);
            st[kb][4 * gI] *= gg[0]; st[kb][4 * gI + 1] *= gg[1]; st[kb][4 * gI + 2] *= gg[2]; st[kb][4 * gI + 3] *= gg[3]; }
#pragma unroll
        for (int ks = 0; ks < 4; ++ks) { const bf16x8 a = *(const LAS bf16x8*)(tb + GL_KD_OFF + (32 * kb + r32) * GL_PITCH + (16 * ks + 8 * hi) * 2);
            st[kb] = __builtin_amdgcn_mfma_f32_32x32x16_bf16(a, vt[ks], st[kb], 0, 0, 0); } }
    f32x16 oc[2];
#pragma unroll
    for (int r = 0; r < 16; ++r) { oc[0][r] = 0.f; oc[1][r] = 0.f; }
#pragma unroll
    for (int kb = 0; kb < 2; ++kb)
#pragma unroll
        for (int jj = 0; jj < 2; ++jj) { v4u bw; bw.x = pk2(st[kb][8 * jj], st[kb][8 * jj + 1]); bw.y = pk2(st[kb][8 * jj + 2], st[kb][8 * jj + 3]);
            bw.z = pk2(st[kb][8 * jj + 4], st[kb][8 * jj + 5]); bw.w = pk2(st[kb][8 * jj + 6], st[kb][8 * jj + 7]);
            const bf16x8 b = __builtin_bit_cast(bf16x8, bw);
#pragma unroll
            for (int cb = 0; cb < 2; ++cb) { const LAS unsigned char* qp = tb + GL_Q_OFF + (32 * cb + r32) * GL_PITCH + (32 * kb + 16 * jj + 4 * hi) * 2;
                const v2u a0 = *(const LAS v2u*)qp, a1 = *(const LAS v2u*)(qp + 16);
                const v4u aw = {a0.x, a0.y, a1.x, a1.y};
                oc[cb] = __builtin_amdgcn_mfma_f32_32x32x16_bf16(__builtin_bit_cast(bf16x8, aw), b, oc[cb], 0, 0, 0); } }
#pragma unroll
    for (int cb = 0; cb < 2; ++cb)
#pragma unroll
        for (int r = 0; r < 16; ++r) { const int p = p0 + 32 * cb + (r & 3) + 8 * (r >> 2) + 4 * hi;
            if (p >= 0) OP[(size_t)p * GVW] = (bf16)(pk2(oc[cb][r], 0.f) & 0xffffu); }
}
__device__ __forceinline__ void gla_chain(Frame& F, int g) {
    const int h = g & 3, kq = (g >> 2) & 3, vh = g >> 4, lane = F.lane, r32 = lane & 31, hi = lane >> 5, tid = F.tid, w = F.wave;
    const char* KDb = (const char*)((const bf16*)(F.ws + WS_KDT) + ((size_t)h * NCHUNK * GDK + 64 * kq) * CHUNK);
    const char* VTb = (const char*)((const bf16*)(F.ws + WS_VT) + ((size_t)h * NCHUNK * GDV + 256 * vh) * CHUNK);
    const char* Qb = (const char*)((const bf16*)(F.ws + WS_GQ) + h * GDK + 64 * kq);
    const char* Gb = (const char*)((const float*)(F.ws + WS_GG) + h * GDK + 64 * kq);
    bf16* OP = (bf16*)(F.ws + WS_OPART) + (size_t)kq * LP * GVW + h * GDV + 256 * vh + 32 * w + r32;
    LAS unsigned char* lds = F.lds + RING_OFF;
    f32x16 st[2];
#pragma unroll
    for (int r = 0; r < 16; ++r) { st[0][r] = 0.f; st[1][r] = 0.f; }
    v4u kdA, qA, vA[4], kdB, qB, vB[4], kdC, qC, vC[4]; float gA, gB, gC;
#define GL_LOAD(ci, KD_, Q_, V_, G_) do { const int ci_ = (ci) < NCHUNK ? (ci) : NCHUNK - 1; int p_ = ci_ * CHUNK - PADL + (tid >> 3); p_ = p_ < 0 ? 0 : p_; \
        KD_ = *(const v4u*)(KDb + (size_t)ci_ * (GDK * CHUNK * 2) + (unsigned)(tid * 16)); \
        Q_ = *(const v4u*)(Qb + (size_t)p_ * (GKW * 2) + (unsigned)((tid & 7) * 16)); \
        _Pragma("unroll") for (int j = 0; j < 4; ++j) V_[j] = *(const v4u*)(VTb + (size_t)ci_ * (GDV * CHUNK * 2) + (unsigned)(tid * 16 + j * 8192)); \
        G_ = *(const float*)(Gb + (size_t)ci_ * (GLAH * GDK * 4) + (unsigned)((tid & 63) * 4)); } while (0)
#define GL_STORE_LDS(bo, KD_, Q_, V_, G_) do { \
        *(LAS v4u*)(lds + (bo) + GL_KD_OFF + (tid >> 3) * GL_PITCH + (tid & 7) * 16) = KD_; \
        *(LAS v4u*)(lds + (bo) + GL_Q_OFF + (tid >> 3) * GL_PITCH + (tid & 7) * 16) = Q_; \
        _Pragma("unroll") for (int j = 0; j < 4; ++j) { const int q = tid + 512 * j; *(LAS v4u*)(lds + (bo) + GL_VT_OFF + (q >> 3) * GL_PITCH + (q & 7) * 16) = V_[j]; } \
        *(LAS float*)(lds + (bo) + GL_G_OFF + 4 * (tid & 63)) = G_; } while (0)
#define GL_BAR() asm volatile("s_waitcnt lgkmcnt(0)\n\ts_barrier" ::: "memory")
#define GL_STEP(ci, KDn_, Qn_, Vn_, Gn_, KDf_, Qf_, Vf_, Gf_) do { \
        GL_BAR(); \
        GL_LOAD((ci) + 3, KDf_, Qf_, Vf_, Gf_); \
        __builtin_amdgcn_sched_barrier(0); \
        GL_STORE_LDS((((ci) + 1) & 1) * GL_BUF, KDn_, Qn_, Vn_, Gn_); \
        __builtin_amdgcn_sched_barrier(0); \
        gla_compute(lds + ((ci) & 1) * GL_BUF, st, OP, (ci) * CHUNK - PADL, w, r32, hi); } while (0)
    GL_LOAD(0, kdA, qA, vA, gA); GL_LOAD(1, kdB, qB, vB, gB); GL_LOAD(2, kdC, qC, vC, gC);
    GL_STORE_LDS(0, kdA, qA, vA, gA);
    static_assert(NCHUNK % 3 == 0, "three rotating register sets");
    for (int ci = 0; ci < NCHUNK; ci += 3) {
        GL_STEP(ci,     kdB, qB, vB, gB, kdA, qA, vA, gA);
        GL_STEP(ci + 1, kdC, qC, vC, gC, kdB, qB, vB, gB);
        GL_STEP(ci + 2, kdA, qA, vA, gA, kdC, qC, vC, gC); }
    __syncthreads();
#undef GL_LOAD
#undef GL_STORE_LDS
#undef GL_STEP
#undef GL_BAR
}

__device__ __forceinline__ fox::BlockRef fox_ref(Frame& F, int item) {
    const int qb = 32 - item / FOXH, h = item % FOXH; fox::BlockRef r;
    r.Q = (const bf16*)(F.ws + WS_FQ) + ((size_t)h * LP + (size_t)qb * fox::QB) * FOXD; r.K = (const bf16*)(F.ws + WS_FK) + (size_t)h * LP * FOXD; r.V = (const bf16*)(F.ws + WS_FV) + (size_t)h * LP * FOXD;
    r.O = (bf16*)(F.ws + WS_OAB) + (size_t)qb * fox::QB * DM + h * FOXD; r.P0 = qb * fox::QB; r.jlo = 0; return r;
}
__device__ __forceinline__ int fox_grab(Frame& F, int slot, int qw) {
    if (F.tid == 0) F.MISC[16 + slot] = __hip_atomic_fetch_add(F.ctl + CW_QUEUE + qw, 1u, RLX_AGENT);
    __syncthreads();
    return (int)F.MISC[16 + slot];
}
__device__ __forceinline__ void fox_phase(Frame& F, int qw) {
    constexpr int NITEMS = 33 * FOXH;
    char* lds = (char*)F.ldsg + RING_OFF;
    int item = fox_grab(F, 0, qw); if (item >= NITEMS) return;
    fox::BlockRef cur = fox_ref(F, item); fox::Seam S;
    fox::fox_prime(cur, lds, S);
    int slot = 1;
    for (;;) {
        { const float* cbg = (const float*)(F.ws + WS_CB) + (size_t)(item % FOXH) * LP; const unsigned* qkb = F.ctl + CW_QKN + 2 * (item % FOXH); const float qk[2] = {sqrtf(__uint_as_float(qkb[0])) * 1.001f, sqrtf(__uint_as_float(qkb[1])) * 1.001f};
          const int NTK = cur.P0 / fox::KVBLK + 4; const float th = cbg[cur.P0] - 110.0f * 11.313708498984761f - 2.0f * qk[0] * qk[1];
          int ln, tt; asm volatile("v_mov_b32 %0, %2\n\tv_mov_b32 %1, %3" : "=v"(ln), "=v"(tt) : "v"(F.lane), "v"(F.tid));
          int cnt = 0;
#pragma unroll
          for (int i = 0; i < 3; ++i) { const int j = ln + 64 * i; const bool pred = j < NTK && cbg[64 * (j < NTK ? j : 0) + 63] < th; cnt += __popcll(__ballot(pred)); }
          cur.jlo = __builtin_amdgcn_readfirstlane(cnt);
          float* cbl = (float*)(lds + fox::CB_OFF); const int i0 = 16 * cur.jlo, n4 = (cur.P0 + fox::QB) / 4;
          for (int i = i0 + tt; i < n4; i += 512) ((f32x4*)cbl)[i] = ((const f32x4*)cbg)[i]; }
        const int nitem = fox_grab(F, slot, qw); slot ^= 1;
        const bool last = nitem >= NITEMS;
        const fox::BlockRef nxt = last ? cur : fox_ref(F, nitem);
        fox::fox_block(cur, nxt, lds, S);
        if (last) break;
        cur = nxt; item = nitem;
    }
}

__device__ __forceinline__ void gla_norm_phase(Frame& F, const Args& A) {
    const bf16* OPa = (const bf16*)(F.ws + WS_OPART); const bf16* GR = (const bf16*)(F.ws + WS_GR); bf16* OAB = (bf16*)(F.ws + WS_OAB);
    const int gw = (int)blockIdx.x * NWAVES + F.wave, NGW = F.G * NWAVES;
    for (int it = gw; it < SEQ * GLAH; it += NGW) { const int pos = NMETA + (it >> 2), h = it & 3;
        float o[8] = {0.f, 0.f, 0.f, 0.f, 0.f, 0.f, 0.f, 0.f};
#pragma unroll
        for (int kq = 0; kq < 4; ++kq) { const v4u pw = *(const v4u*)(OPa + ((size_t)kq * LP + pos) * GVW + h * GDV + 8 * F.lane);
            o[0] += bf_lo(pw.x); o[1] += bf_hi(pw.x); o[2] += bf_lo(pw.y); o[3] += bf_hi(pw.y); o[4] += bf_lo(pw.z); o[5] += bf_hi(pw.z); o[6] += bf_lo(pw.w); o[7] += bf_hi(pw.w); }
        const float ssq = wave_sum((o[0] * o[0] + o[1] * o[1]) + (o[2] * o[2] + o[3] * o[3]) + (o[4] * o[4] + o[5] * o[5]) + (o[6] * o[6] + o[7] * o[7]));
        const float rstd = 1.0f / sqrtf(ssq * (1.f / GDV) + EPS);
        const f32x4 g0 = *(const f32x4*)(A.in[I_GNG] + 8 * F.lane), g1 = *(const f32x4*)(A.in[I_GNG] + 8 * F.lane + 4);
        const v4u rw = *(const v4u*)(GR + (size_t)pos * GVW + h * GDV + 8 * F.lane);
        v4u wv; wv.x = pk2(o[0] * rstd * g0[0] * bf_lo(rw.x), o[1] * rstd * g0[1] * bf_hi(rw.x)); wv.y = pk2(o[2] * rstd * g0[2] * bf_lo(rw.y), o[3] * rstd * g0[3] * bf_hi(rw.y));
        wv.z = pk2(o[4] * rstd * g1[0] * bf_lo(rw.z), o[5] * rstd * g1[1] * bf_hi(rw.z)); wv.w = pk2(o[6] * rstd * g1[2] * bf_lo(rw.w), o[7] * rstd * g1[3] * bf_hi(rw.w));
        *(v4u*)(OAB + (size_t)pos * DM + FOXW + h * GDV + 8 * F.lane) = wv; }
}

constexpr int N_PHASES = 12;

__global__ void __launch_bounds__(NWAVES * 64, 2) mk_fwd(Args args) {
    extern __shared__ __attribute__((aligned(16))) unsigned char lds[];
    Frame F;
    F.lds = (LAS unsigned char*)lds; F.ldsg = lds;
    F.MISC = (volatile LAS unsigned*)(F.lds + MISC_OFF);
    F.tid = threadIdx.x; F.lane = F.tid & 63; F.wave = __builtin_amdgcn_readfirstlane(F.tid >> 6);
    F.G = gridDim.x;
    F.ws = args.ws; F.ctl = (unsigned*)(args.ws + WS_CTL);
    unsigned char* ws = args.ws;
    for (int u = F.tid; u < (LDS_BYTES - LDSCTL_OFF) / 4; u += NWAVES * 64) ((LAS unsigned*)(F.lds + LDSCTL_OFF))[u] = 0u;
    __syncthreads();
    XcdBarrier bar; bar.bar = F.ctl + CW_BAR; bar.x = 0; bar.st = nullptr;
    if (MK_N_LAUNCHES == 1) bar = xcd_barrier_post(F.ctl + CW_BAR, F.MISC + 8);
#define GRID_BAR() do { if (MK_N_LAUNCHES == 1) xcd_barrier(bar); } while (0)
    const int lo = args.ph_lo, hi = args.ph_hi;
#ifdef ONLY_PHASE
#define IN(k) ((k) == ONLY_PHASE && lo <= (k) && (k) < hi)
#else
#define IN(k) (lo <= (k) && (k) < hi)
#endif
#define SEAM(k) do { if (IN((k) + 1)) GRID_BAR(); } while (0)

#define W1A ((bf16*)(ws + WS_W1A))
#define W1B ((bf16*)(ws + WS_W1B))
#define WINb ((bf16*)(ws + WS_WIN))
#define WP ((bf16*)(ws + WS_WP))
#define WO ((bf16*)(ws + WS_WO))
#define W2A ((bf16*)(ws + WS_W2A))
#define W2B ((bf16*)(ws + WS_W2B))
#define ABUF ((bf16*)(ws + WS_ABUF))
#define HID ((bf16*)(ws + WS_HID))
#define H ((bf16*)(ws + WS_H))
#define GA ((bf16*)(ws + WS_GA))
#define GB ((bf16*)(ws + WS_GB))
#define OAB ((bf16*)(ws + WS_OAB))
#define Y ((bf16*)(ws + WS_Y))
#define YBF ((bf16*)(ws + WS_YBF))
#define A8G ((const bf16*)(ws + WS_A8))
#define WG8 ((const bf16*)(ws + WS_WG8))
#define RS2 ((const float*)(ws + WS_RS2))
#define WMAXG ((const float*)(ws + WS_WCLIP) + WCH_G)
#define SS2 ((ssq_t*)(F.ctl + CW_SS2))
#define SS3 ((ssq_t*)(F.ctl + CW_SS3))
#define SS4 ((ssq_t*)(F.ctl + CW_SS4))
    const int c = (int)blockIdx.x;

    if (IN(0)) { p0_prologue(F, args); SEAM(0); }
    if (IN(1)) { quantise_ffn1(F, args); GRID_BAR();
        skinny_p1(F, ws + WS_A8, (const float*)(ws + WS_RS1), ws + WS_W1A, (const float*)(ws + WS_WCLIP) + WCH_F1, HID);
        pg8::Gemm g{A8G, W1A, DM / 2, DM / 2, DM / 2}; pg8::GridOrder S; S.init(32, 86, F.G, c, 0, 0);
        EpiSwiGLUQ E{HID, (const float*)(ws + WS_RS1), (const float*)(ws + WS_WCLIP) + WCH_F1};
        pg8::gemm_phase<EpiSwiGLUQ, pg8::GridOrder, true, false, true>(F.lds + RING_OFF, g, S, E); SEAM(1); }
    if (IN(2)) { skinny_p2(F, args, HID, W1B, H, ABUF, SS2);
        pg8::Gemm g{HID, W1B, DFF, DFF, DFF}; pg8::GridOrder S; S.init(32, 16, F.G, c, 0, 0);
        EpiResid<0> E{args.in[I_X], args.in[I_META], H, nullptr, ABUF, args.in[I_NMIXG], SS2, 0.5f, H};
        pg8::gemm_phase<EpiResid<0>, pg8::GridOrder>(F.lds + RING_OFF, g, S, E); SEAM(2); }
    if (IN(3)) { skinny_p3(F, ABUF, WINb, SS2);
        pg8::Gemm g{ABUF, WINb, DM, DM, DM}; pg8::GridOrder S; S.init(32, 48, F.G, c, 0, 0); EpiWin E{SS2, ws};
        pg8::gemm_phase<EpiWin, pg8::GridOrder>(F.lds + RING_OFF, g, S, E); SEAM(3); }
    if (IN(4)) {
        if (F.wave >= 4) quantise_late(F, args, c, F.G, F.wave - 4, 4, RING_OFF + 16384, 0, 8);
        else { unsigned phase = 0u; int buf = 0;
            for (int it = c; it < NCHUNK * GLAH; it += F.G) { prep_gla_item4(F, args, it >> 2, it & 3, buf, phase); buf ^= 1; }
            for (int it = c; it < 2 * FOXH * 33; it += F.G) { prep_fox_norms(F, it, F.tid); prep_fox_norms(F, it, F.tid + 256); }
            if (c < FOXH) prep_fox_cumsum4(F, args, c, phase);
            quant_rows(F, ABUF, SS2, ws + WS_A8, (float*)(ws + WS_RS2), L, F.wave, 4); }
        __syncthreads();
        SEAM(4); }
    if (IN(5)) {
        const bool gla_role = c < 64 && (c & 7) < 4;
        const int gemm_idx = c < 64 ? (c >> 3) * 4 + ((c & 7) - 4) : c - 32;
        skinny_gates(F);
        if (gla_role) gla_chain(F, (c & 7) + 4 * (c >> 3));
        else { pg8::Gemm g{A8G, WG8, DM / 2, DM / 2, DM / 2}; pg8::GridOrder S; S.init(28, 32, F.G - GLA_WGS, gemm_idx, 0, 0); EpiGate E{RS2, WMAXG, GA, GB, 2};
               pg8::gemm_phase<EpiGate, pg8::GridOrder, true, false, true>(F.lds + RING_OFF, g, S, E); }
        { pg8::Gemm g{A8G, WG8, DM / 2, DM / 2, DM / 2}; HalfOrder S; S.c = c; EpiGate E{RS2, WMAXG, GA, GB, 1};
          pg8::gemm_phase<EpiGate, HalfOrder, true, true, true>(F.lds + RING_OFF, g, S, E); }
        fox_phase(F, 0);
        SEAM(5); }
    if (IN(6)) { gla_norm_phase(F, args); SEAM(6); }
    if (IN(7)) { pg8::Gemm g{OAB, WP, DM, DM, FOXW}; pg8::GridOrder S; S.init(32, 16, F.G, c, NMETA, 0);
        EpiProj<0> E{GA, Y, YBF};
        pg8::gemm_phase<EpiProj<0>, pg8::GridOrder>(F.lds + RING_OFF, g, S, E); SEAM(7); }
    if (IN(8)) { pg8::Gemm g{OAB + FOXW, WP + FOXW, DM, DM, GVW}; pg8::GridOrder S; S.init(32, 16, F.G, c, NMETA, 0);
        EpiProj<1> E{GB, Y, YBF};
        pg8::gemm_phase<EpiProj<1>, pg8::GridOrder>(F.lds + RING_OFF, g, S, E); SEAM(8); }
    if (IN(9)) { pg8::Gemm g{YBF, WO, DM, DM, DM}; PanelOrder S; S.G = F.G; S.c = c;
        EpiResidQ E{H, args.in[I_N2G], SS3, F.ctl + CW_AMAX3, ws + WS_A8, (float*)(ws + WS_RS3), F.ctl + CW_PANEL9, F.ctl + CW_BAR};
        pg8::gemm_phase<EpiResidQ, PanelOrder>(F.lds + RING_OFF, g, S, E); SEAM(9); }
    if (IN(10)) { pg8::Gemm g{A8G, W2A, DM / 2, DM / 2, DM / 2}; pg8::GridOrder S; S.init(32, 86, F.G, c, NMETA, 0);
        EpiSwiGLUQ E{HID, (const float*)(ws + WS_RS3), (const float*)(ws + WS_WCLIP) + WCH_F2};
        pg8::gemm_phase<EpiSwiGLUQ, pg8::GridOrder, true, false, true>(F.lds + RING_OFF, g, S, E); SEAM(10); }
    if (IN(11)) { pg8::Gemm g{HID, W2B, DFF, DFF, DFF}; PanelOrder S; S.G = F.G; S.c = c;
        EpiFinal E{H, args.out, args.in[I_NFG], SS4, F.ctl + CW_PANEL, F.ctl + CW_BAR, 0.5f};
        pg8::gemm_phase<EpiFinal, PanelOrder>(F.lds + RING_OFF, g, S, E); }
#undef A8G
#undef WG8
#undef RS2
#undef WMAXG
#undef IN
#undef SEAM
#undef GRID_BAR
#undef W1A
#undef W1B
#undef WINb
#undef WP
#undef WO
#undef W2A
#undef W2B
#undef ABUF
#undef HID
#undef H
#undef GA
#undef GB
#undef OAB
#undef Y
#undef YBF
#undef SS2
#undef SS3
#undef SS4
}

extern "C" void kernel_launch(void* const* d_in, const int* in_sizes, int n_in, void* d_out, int out_size, void* d_ws, size_t ws_size, hipStream_t stream) {
    static int grid = 0;
    if (grid == 0) {
        if (n_in != 21 || in_sizes[0] != SEQ * DM || out_size != SEQ * DM || ws_size < WS_END) {
            fprintf(stderr, "kernel_launch: shape / workspace mismatch (n_in %d, in0 %d, out %d, ws %zu < %zu?)\n", n_in, n_in > 0 ? in_sizes[0] : -1, out_size, ws_size, (size_t)WS_END); grid = -1; return; }
        int dev = 0, cus = 0, per_cu = 0;
        if (hipGetDevice(&dev) != hipSuccess || hipDeviceGetAttribute(&cus, hipDeviceAttributeMultiprocessorCount, dev) != hipSuccess) { fprintf(stderr, "kernel_launch: device query failed\n"); grid = -1; return; }
        if (hipFuncSetAttribute((const void*)mk_fwd, hipFuncAttributeMaxDynamicSharedMemorySize, LDS_BYTES) != hipSuccess) { fprintf(stderr, "kernel_launch: hipFuncSetAttribute failed\n"); grid = -1; return; }
        if (hipOccupancyMaxActiveBlocksPerMultiprocessor(&per_cu, (const void*)mk_fwd, NWAVES * 64, LDS_BYTES) != hipSuccess || per_cu < 1)
            fprintf(stderr, "kernel_launch: note: occupancy query reports %d workgroups per CU\n", per_cu);
        (void)hipGetLastError();
        grid = cus;
    }
    if (grid < 0) return;
    if (hipMemsetAsync((char*)d_ws + WS_CTL, 0, CTL_ZERO_BYTES, stream) != hipSuccess) { fprintf(stderr, "kernel_launch: memset failed\n"); return; }
    Args a{};
    for (int i = 0; i < 21; ++i) a.in[i] = (const float*)d_in[i];
    a.out = (float*)d_out; a.ws = (unsigned char*)d_ws;
    if (MK_N_LAUNCHES == 1) { a.ph_lo = 0; a.ph_hi = N_PHASES; hipLaunchKernelGGL(mk_fwd, dim3(grid), dim3(NWAVES * 64), LDS_BYTES, stream, a); }
    else for (int p = 0; p < N_PHASES; ++p) { a.ph_lo = p; a.ph_hi = p + 1; hipLaunchKernelGGL(mk_fwd, dim3(grid), dim3(NWAVES * 64), LDS_BYTES, stream, a); }
    const hipError_t le = hipPeekAtLastError();
    if (le != hipSuccess) fprintf(stderr, "kernel_launch: launch failed: %s\n", hipGetErrorName(le));
}
```
